# Optimizing an MI355X kernel written in HIP

```python
import math
import jax, jax.numpy as jnp
from jax import lax
import numpy as np

D_MODEL = 2048
BATCH = 4
SEQ = 4096
DEPTH = 4

D_FF = 5632
DIFF_HEADS = 4
DIFF_HEAD_DIM = 64
MLA_HEADS = 6
MLA_Q_LORA = 512
MLA_KV_LORA = 512
MLA_NOPE = 128
MLA_ROPE = 64
MLA_V = 128
DIL_HEADS = 6
DIL_HEAD_DIM = 128
DILATED_PATTERNS = ((128, 1), (512, 4), (2048, 16))
DIL_BLOCK = 128
MEM_LEN = 256
CROSS_HEADS = 4
CROSS_HEAD_DIM = 128
Q_BLOCK = 128
ROPE_THETA = 10000.0
MAX_START = 1024
NEG = -1e30

A_COLS = 4 * DIFF_HEADS * DIFF_HEAD_DIM + DIFF_HEADS * 2 * DIFF_HEAD_DIM
B_COLS = MLA_Q_LORA + MLA_KV_LORA + MLA_ROPE
C_COLS = 3 * DIL_HEADS * DIL_HEAD_DIM
N_IN = A_COLS + B_COLS + C_COLS
MIX_OUT = DIFF_HEADS * 2 * DIFF_HEAD_DIM + MLA_HEADS * MLA_V + DIL_HEADS * DIL_HEAD_DIM

kernel_name = 'hybrid_parallel_headgroup_decoder'


def rmsnorm(x, g, eps=1e-6):
    xf = x.astype(jnp.float32)
    y = xf * lax.rsqrt(jnp.mean(xf * xf, axis=-1, keepdims=True) + eps)
    return (y * g.astype(jnp.float32)).astype(x.dtype)


def swiglu(x, w_gate, w_up, w_down):
    return (jax.nn.silu(x @ w_gate) * (x @ w_up)) @ w_down


def rope_tables(positions, dim):
    inv = 1.0 / (ROPE_THETA ** (jnp.arange(0, dim, 2, dtype=jnp.float32) / dim))
    ang = positions.astype(jnp.float32)[..., None] * inv
    return jnp.cos(ang), jnp.sin(ang)


def apply_rope(x, cos, sin):
    x1, x2 = jnp.split(x, 2, axis=-1)
    c = cos[:, :, None, :].astype(x.dtype)
    s = sin[:, :, None, :].astype(x.dtype)
    return jnp.concatenate([x1 * c - x2 * s, x1 * s + x2 * c], axis=-1)


def heads_first(a):
    return jnp.swapaxes(a, 1, 2)


def heads_last(a):
    B, H, S, D = a.shape
    return jnp.swapaxes(a, 1, 2).reshape(B, S, H * D)


def causal_attention(q, k, v, scale):
    B, H, S, Dk = q.shape
    Dv = v.shape[-1]
    nb = S // Q_BLOCK
    qb = q.reshape(B, H, nb, Q_BLOCK, Dk).transpose(2, 0, 1, 3, 4)
    kpos = jnp.arange(S)

    def one_block(args):
        qi, i = args
        s = jnp.einsum('bhqd,bhkd->bhqk', qi, k).astype(jnp.float32) * scale
        qpos = i * Q_BLOCK + jnp.arange(Q_BLOCK)
        s = jnp.where(kpos[None, :] <= qpos[:, None], s, NEG)
        p = jax.nn.softmax(s, axis=-1)
        return jnp.einsum('bhqk,bhkd->bhqd', p.astype(v.dtype), v)

    out = lax.map(one_block, (qb, jnp.arange(nb)))
    return out.transpose(1, 2, 0, 3, 4).reshape(B, H, S, Dv)


def dilated_window_attention(q, k, v, window, dilation, scale):
    B, H, S, D = q.shape
    Lb = DIL_BLOCK
    span = window // dilation
    unit = dilation * Lb
    Sp = -(-S // unit) * unit
    M = Sp // dilation
    nb = M // Lb

    def to_blocks(a):
        a = jnp.pad(a, ((0, 0), (0, 0), (0, Sp - S), (0, 0))).reshape(B, H, M, dilation, D)
        return jnp.swapaxes(a, 2, 3).reshape(B, H, dilation, nb, Lb, D)

    def with_prev(a):
        prev = jnp.pad(a, ((0, 0), (0, 0), (0, 0), (1, 0), (0, 0), (0, 0)))[:, :, :, :-1]
        return jnp.concatenate([prev, a], axis=4)

    qb = to_blocks(q)
    kk = with_prev(to_blocks(k))
    vv = with_prev(to_blocks(v))
    s = jnp.einsum('bhrnqd,bhrnkd->bhrnqk', qb, kk).astype(jnp.float32) * scale
    qi = jnp.arange(Lb)[:, None]
    kj = jnp.arange(2 * Lb)[None, :]
    dist = qi + Lb - kj
    blk = jnp.arange(nb)[:, None, None]
    valid = (dist >= 0) & (dist <= span) & (blk * Lb + kj - Lb >= 0)
    s = jnp.where(valid, s, NEG)
    m = jnp.max(s, axis=-1, keepdims=True)
    e = jnp.exp(s - m)
    l = jnp.sum(e, axis=-1, keepdims=True)
    o = jnp.einsum('bhrnqk,bhrnkd->bhrnqd', (e / l).astype(v.dtype), vv)
    lse = (m + jnp.log(l))[..., 0]

    def from_blocks(a):
        tail = a.shape[5:]
        a = a.reshape((B, H, dilation, M) + tail)
        a = jnp.swapaxes(a, 2, 3).reshape((B, H, Sp) + tail)
        return a[:, :, :S]

    return from_blocks(o), from_blocks(lse)


def diff_attention(u, lam_params, subln, lam_init, cos, sin):
    B, S, _ = u.shape
    n = DIFF_HEADS * DIFF_HEAD_DIM
    q1, q2, k1, k2, v = jnp.split(u, [n, 2 * n, 3 * n, 4 * n], axis=-1)
    shp = (B, S, DIFF_HEADS, DIFF_HEAD_DIM)
    q1, q2, k1, k2 = [heads_first(apply_rope(t.reshape(shp), cos, sin)) for t in (q1, q2, k1, k2)]
    vh = heads_first(v.reshape(B, S, DIFF_HEADS, 2 * DIFF_HEAD_DIM))
    scale = DIFF_HEAD_DIM ** -0.5
    a1 = causal_attention(q1, k1, vh, scale)
    a2 = causal_attention(q2, k2, vh, scale)
    lp = lam_params.astype(jnp.float32)
    lam = jnp.exp(jnp.sum(lp[0] * lp[1])) - jnp.exp(jnp.sum(lp[2] * lp[3])) + lam_init
    o = jnp.swapaxes(a1 - lam.astype(a1.dtype) * a2, 1, 2)
    o = rmsnorm(o, subln, eps=1e-5) * (1.0 - lam_init)
    return o.reshape(B, S, -1)


def mla_attention(u, q_norm, w_uq, kv_norm, w_ukv, cos, sin):
    B, S, _ = u.shape
    c_q, c_kv, k_rope = jnp.split(u, [MLA_Q_LORA, MLA_Q_LORA + MLA_KV_LORA], axis=-1)
    q = (rmsnorm(c_q, q_norm) @ w_uq).reshape(B, S, MLA_HEADS, MLA_NOPE + MLA_ROPE)
    q_nope, q_rope = jnp.split(q, [MLA_NOPE], axis=-1)
    kv = (rmsnorm(c_kv, kv_norm) @ w_ukv).reshape(B, S, MLA_HEADS, MLA_NOPE + MLA_V)
    k_nope, v = jnp.split(kv, [MLA_NOPE], axis=-1)
    q_rope = apply_rope(q_rope, cos, sin)
    k_rope = apply_rope(k_rope[:, :, None, :], cos, sin)
    q = jnp.concatenate([q_nope, q_rope], axis=-1)
    k = jnp.concatenate([k_nope, jnp.broadcast_to(k_rope, (B, S, MLA_HEADS, MLA_ROPE))], axis=-1)
    o = causal_attention(heads_first(q), heads_first(k), heads_first(v), (MLA_NOPE + MLA_ROPE) ** -0.5)
    return heads_last(o)


def dilated_attention(u, cos, sin):
    B, S, _ = u.shape
    shp = (B, S, DIL_HEADS, DIL_HEAD_DIM)
    q, k, v = [t.reshape(shp) for t in jnp.split(u, 3, axis=-1)]
    q = heads_first(apply_rope(q, cos, sin))
    k = heads_first(apply_rope(k, cos, sin))
    v = heads_first(v)
    outs, lses = [], []
    for window, dilation in DILATED_PATTERNS:
        o, lse = dilated_window_attention(q, k, v, window, dilation, DIL_HEAD_DIM ** -0.5)
        outs.append(o)
        lses.append(lse)
    wts = jax.nn.softmax(jnp.stack(lses, axis=0), axis=0)
    o = jnp.einsum('gbhs,gbhsd->bhsd', wts.astype(v.dtype), jnp.stack(outs, axis=0))
    return heads_last(o)


def cross_attention(h, memn, wq, wkv, wo):
    B, S, _ = h.shape
    Mm = memn.shape[1]
    q = (h @ wq).reshape(B, S, CROSS_HEADS, CROSS_HEAD_DIM)
    kv = (memn @ wkv).reshape(B, Mm, 2, CROSS_HEADS, CROSS_HEAD_DIM)
    k, v = kv[:, :, 0], kv[:, :, 1]
    s = jnp.einsum('bshd,bmhd->bhsm', q, k).astype(jnp.float32) * (CROSS_HEAD_DIM ** -0.5)
    p = jax.nn.softmax(s, axis=-1)
    o = jnp.einsum('bhsm,bmhd->bshd', p.astype(v.dtype), v).reshape(B, S, CROSS_HEADS * CROSS_HEAD_DIM)
    return o @ wo


def setup_inputs(seed: int = 0) -> dict:
    key = jax.random.key(seed)
    ks = jax.random.split(key, 26)
    L, D, F = DEPTH, D_MODEL, D_FF
    f32 = jnp.float32

    def w(k, shape, fan_in):
        return jax.random.normal(k, shape, f32) * (fan_in ** -0.5)

    def gain(k, shape):
        return 1.0 + 0.02 * jax.random.normal(k, shape, f32)

    x = jax.random.normal(ks[0], (BATCH, SEQ, D), f32)
    mem = jax.random.normal(ks[1], (BATCH, MEM_LEN, D), f32)
    start = jax.random.randint(ks[2], (BATCH, 1), 0, MAX_START, dtype=jnp.int32)
    positions = start + jnp.arange(SEQ, dtype=jnp.int32)[None, :]
    return {
        'x': x,
        'mem': mem,
        'positions': positions,
        'ffn1_norm': gain(ks[3], (L, D)),
        'ffn1_gate': w(ks[4], (L, D, F), D),
        'ffn1_up': w(ks[5], (L, D, F), D),
        'ffn1_down': w(ks[6], (L, F, D), F),
        'mix_norm': gain(ks[7], (L, D)),
        'w_in': w(ks[8], (L, D, N_IN), D),
        'diff_lambda': 0.1 * jax.random.normal(ks[9], (L, 4, DIFF_HEAD_DIM), f32),
        'diff_subln': gain(ks[10], (L, 2 * DIFF_HEAD_DIM)),
        'mla_q_norm': gain(ks[11], (L, MLA_Q_LORA)),
        'mla_w_uq': w(ks[12], (L, MLA_Q_LORA, MLA_HEADS * (MLA_NOPE + MLA_ROPE)), MLA_Q_LORA),
        'mla_kv_norm': gain(ks[13], (L, MLA_KV_LORA)),
        'mla_w_ukv': w(ks[14], (L, MLA_KV_LORA, MLA_HEADS * (MLA_NOPE + MLA_V)), MLA_KV_LORA),
        'w_out': w(ks[15], (L, MIX_OUT, D), MIX_OUT),
        'cross_norm': gain(ks[16], (L, D)),
        'mem_norm': gain(ks[17], (L, D)),
        'cross_wq': w(ks[18], (L, D, CROSS_HEADS * CROSS_HEAD_DIM), D),
        'cross_wkv': w(ks[19], (L, D, 2 * CROSS_HEADS * CROSS_HEAD_DIM), D),
        'cross_wo': w(ks[20], (L, CROSS_HEADS * CROSS_HEAD_DIM, D), CROSS_HEADS * CROSS_HEAD_DIM),
        'ffn2_norm': gain(ks[21], (L, D)),
        'ffn2_gate': w(ks[22], (L, D, F), D),
        'ffn2_up': w(ks[23], (L, D, F), D),
        'ffn2_down': w(ks[24], (L, F, D), F),
        'final_norm': gain(ks[25], (D,)),
    }


def reference(x, mem, positions, ffn1_norm, ffn1_gate, ffn1_up, ffn1_down, mix_norm, w_in,
              diff_lambda, diff_subln, mla_q_norm, mla_w_uq, mla_kv_norm, mla_w_ukv, w_out,
              cross_norm, mem_norm, cross_wq, cross_wkv, cross_wo,
              ffn2_norm, ffn2_gate, ffn2_up, ffn2_down, final_norm):
    cos64, sin64 = rope_tables(positions, DIFF_HEAD_DIM)
    cos128, sin128 = rope_tables(positions, DIL_HEAD_DIM)
    h = x
    for l in range(DEPTH):
        lam_init = 0.8 - 0.6 * math.exp(-0.3 * l)
        h = h + 0.5 * swiglu(rmsnorm(h, ffn1_norm[l]), ffn1_gate[l], ffn1_up[l], ffn1_down[l])
        u = rmsnorm(h, mix_norm[l]) @ w_in[l]
        u_a, u_b, u_c = jnp.split(u, [A_COLS, A_COLS + B_COLS], axis=-1)
        y_a = diff_attention(u_a, diff_lambda[l], diff_subln[l], lam_init, cos64, sin64)
        y_b = mla_attention(u_b, mla_q_norm[l], mla_w_uq[l], mla_kv_norm[l], mla_w_ukv[l], cos64, sin64)
        y_c = dilated_attention(u_c, cos128, sin128)
        h = h + jnp.concatenate([y_a, y_b, y_c], axis=-1) @ w_out[l]
        h = h + cross_attention(rmsnorm(h, cross_norm[l]), rmsnorm(mem, mem_norm[l]),
                                cross_wq[l], cross_wkv[l], cross_wo[l])
        h = h + 0.5 * swiglu(rmsnorm(h, ffn2_norm[l]), ffn2_gate[l], ffn2_up[l], ffn2_down[l])
    return rmsnorm(h, final_norm)
```

```cpp
#include <hip/hip_runtime.h>
#include <cstdio>
#include <cstdint>
#include <cmath>
#ifndef PRESC_DIFF
#define PRESC_DIFF 1
#endif
#ifndef PRESC_CROSS
#define PRESC_CROSS 1
#endif
#ifndef PRESC_MLA
#define PRESC_MLA 1
#endif
#define QS_LOG2E 1.4426950408889634f
#define QS_DIFF (0.125f * QS_LOG2E)
#define QS_MLA (0.07216878364870322f * QS_LOG2E)
#define QS_CROSS (0.08838834764831845f * QS_LOG2E)
#define QS_DIL (0.08838834764831845f * QS_LOG2E)
#ifndef PRESC_DIL
#define PRESC_DIL 1
#endif
namespace pg8 {
#define PG8_LAS __attribute__((address_space(3)))
typedef unsigned short bf16_t;
typedef short bf16x8 __attribute__((ext_vector_type(8)));
typedef float f32x4 __attribute__((ext_vector_type(4)));
typedef unsigned u32x4 __attribute__((ext_vector_type(4)));
constexpr int BM = 256, BK = 64, HALF = 128, HTB = HALF * BK * 2  , STAGE_BYTES = 8 * HTB, NXCD = 8, WGM = 8;

__host__ __device__ __forceinline__ int lds_byte(int r, int c) { const int st = (r >> 4) * 2 + (c >> 5), rr = r & 15, cc = c & 31, ob = rr * 64 + cc * 2; return st * 1024 + (ob ^ (((ob >> 9) & 1) << 5)); }
__host__ __device__ __forceinline__ void stage_rc(int b, int& R, int& C) { const int st = b / 1024, sb = b % 1024, swz = sb ^ (((sb >> 9) & 1) << 5); R = (st >> 1) * 16 + swz / 64; C = (st & 1) * 32 + (swz % 64) / 2; }
__host__ __device__ __forceinline__ int perm32(int rho) { const int n = rho >> 4, i = rho & 15; return 8 * (i >> 2) + 4 * n + (i & 3); }

struct Unit { int pm, pn; };
struct Gemm { const bf16_t* A; const bf16_t* Bt; int M, N, K, lda, ldb; };

struct StaticOrder {
    int nM, nN, nwg, G, c;
    __host__ __device__ __forceinline__ void init(int M, int N, int G_, int c_) { nM = M / BM; nN = N / BM; nwg = nM * nN; G = G_; c = c_; }
    __host__ __device__ __forceinline__ bool next(int i, Unit& u) const {
        const long L = (long)i * G + c; if (L >= nwg) return false;
        int wgid = (int)L; { const int q = nwg / NXCD, r = nwg % NXCD, xcd = wgid % NXCD, off = wgid / NXCD; wgid = (xcd < r ? xcd * (q + 1) : r * (q + 1) + (xcd - r) * q) + off; }
        const int nig = WGM * nN, gid = wgid / nig, fm = gid * WGM, gsz = (nM - fm) < WGM ? (nM - fm) : WGM;
        u.pm = fm + ((wgid % nig) % gsz); u.pn = (wgid % nig) / gsz; return true;
    }
    __device__ __forceinline__ void a_ready(const Unit&) const {}
    __device__ __forceinline__ void done(const Unit&) const {}
};

__device__ __forceinline__ unsigned cvt_pk_bf16(float lo, float hi) { unsigned r; asm volatile("v_cvt_pk_bf16_f32 %0, %1, %2" : "=v"(r) : "v"(lo), "v"(hi)); return r; }
typedef float f32x2 __attribute__((ext_vector_type(2)));
struct EpiBf16 {
    static constexpr bool PERM = true, AFTER_DRAIN = false;
    bf16_t* O; int ldc;
    __device__ __forceinline__ void operator()(const f32x4 (&acc)[2][2][4][2], const Unit& u, int wr, int wc, int fr, int fq) const {
        const int row0 = u.pm * BM + wr * 64 + fr, col0 = u.pn * BM + wc * 32 + 8 * fq;
#pragma unroll
        for (int ai = 0; ai < 2; ++ai)
#pragma unroll
            for (int m = 0; m < 4; ++m) { bf16_t* rowp = O + (size_t)(row0 + ai * HALF + m * 16) * ldc + col0;
#pragma unroll
                for (int bj = 0; bj < 2; ++bj) { const f32x4 v0 = acc[ai][bj][m][0], v1 = acc[ai][bj][m][1];
                    u32x4 w; w.x = cvt_pk_bf16(v0[0], v0[1]); w.y = cvt_pk_bf16(v0[2], v0[3]); w.z = cvt_pk_bf16(v1[0], v1[1]); w.w = cvt_pk_bf16(v1[2], v1[3]);
                    *(u32x4*)(rowp + bj * HALF) = w; } }
    }
};
struct EpiResid {
    static constexpr bool PERM = false, AFTER_DRAIN = false;
    const float* base; float* out; int ldc; float scale;
    __device__ __forceinline__ void operator()(const f32x4 (&acc)[2][2][4][2], const Unit& u, int wr, int wc, int fr, int fq) const {
        const int col0 = u.pn * BM + wc * 32 + 4 * fq;
#pragma unroll
        for (int ai = 0; ai < 2; ++ai)
#pragma unroll
            for (int m = 0; m < 4; ++m) { const size_t off = (size_t)(u.pm * BM + ai * HALF + wr * 64 + m * 16 + fr) * ldc + col0;
#pragma unroll
                for (int bj = 0; bj < 2; ++bj)
#pragma unroll
                    for (int n = 0; n < 2; ++n) { const f32x4 bs = *(const f32x4*)(base + off + bj * HALF + n * 16); *(f32x4*)(out + off + bj * HALF + n * 16) = bs + acc[ai][bj][m][n] * scale; }
                asm volatile("" ::: "memory"); }
    }
};

__device__ __forceinline__ float bperm_f(int src_lane, float v) { return __builtin_bit_cast(float, __builtin_amdgcn_ds_bpermute(src_lane << 2, __builtin_bit_cast(int, v))); }
template <int NPART> __device__ __forceinline__ void row_rstd8(const float* S, int row0  , int fr, int fq, float inv_n, float eps, float (&rs)[2][4]) {
    float mine[2];
#pragma unroll
    for (int j = 0; j < 2; ++j) { const f32x4* p = (const f32x4*)(S + (size_t)(row0 + 128 * (fq >> 1) + 16 * (2 * (fq & 1) + j) + fr) * NPART); float s = 0.f;
#pragma unroll
        for (int i = 0; i < NPART / 4; ++i) { const f32x4 v = p[i]; s += (v.x + v.y) + (v.z + v.w); }
        mine[j] = 1.0f / __builtin_sqrtf(s * inv_n + eps); }
#pragma unroll
    for (int ai = 0; ai < 2; ++ai)
#pragma unroll
        for (int mh = 0; mh < 2; ++mh) { const int src = fr + 16 * (2 * ai + mh); rs[ai][2 * mh] = bperm_f(src, mine[0]); rs[ai][2 * mh + 1] = bperm_f(src, mine[1]); }
}
struct RstdCache { unsigned tab; int pm; };
template <int NPART> __device__ __forceinline__ void rstd8_cached(const RstdCache& rc, const float* S, const Unit& u, int wr, int fr, int fq, float inv_n, float eps, float (&rs)[2][4]) {
    if (u.pm == rc.pm) {
#pragma unroll
        for (int ai = 0; ai < 2; ++ai)
#pragma unroll
            for (int m = 0; m < 4; ++m) rs[ai][m] = ((const PG8_LAS float*)(size_t)rc.tab)[ai * HALF + wr * 64 + m * 16 + fr];
    } else row_rstd8<NPART>(S, u.pm * BM + wr * 64, fr, fq, inv_n, eps, rs);
}
template <int NPART> __device__ __forceinline__ RstdCache rstd_cache_fill(PG8_LAS float* tab, const float* S, int pm, int tid, float inv_n, float eps) {
    if (tid < 256) { const f32x4* p = (const f32x4*)(S + (size_t)(pm * BM + tid) * NPART); float s = 0.f;
#pragma unroll
        for (int i = 0; i < NPART / 4; ++i) { const f32x4 v = p[i]; s += (v.x + v.y) + (v.z + v.w); }
        tab[tid] = 1.0f / __builtin_sqrtf(s * inv_n + eps); }
    __syncthreads();
    RstdCache rc; rc.tab = (unsigned)(size_t)tab; rc.pm = pm; return rc;
}
struct EpiSwiglu {
    static constexpr bool PERM = true, AFTER_DRAIN = false;
    bf16_t* O; int ldc; const float* S; RstdCache rc;
    __device__ __forceinline__ void operator()(const f32x4 (&acc)[2][2][4][2], const Unit& u, int wr, int wc, int fr, int fq) const {
        float rs[2][4];
        if (S) rstd8_cached<32>(rc, S, u, wr, fr, fq, 1.0f / 2048.0f, 1e-6f, rs);
        else {
#pragma unroll
            for (int a = 0; a < 2; ++a)
#pragma unroll
                for (int m = 0; m < 4; ++m) rs[a][m] = 1.0f; }
        const int row0 = u.pm * BM + wr * 64 + fr, col0 = u.pn * HALF + wc * 32 + 8 * fq;
#pragma unroll
        for (int ai = 0; ai < 2; ++ai)
#pragma unroll
            for (int m = 0; m < 4; ++m) { const float r = rs[ai][m], rn = r * -1.4426950408889634f, rr = r * r; float h[8];
#pragma unroll
                for (int n = 0; n < 2; ++n)
#pragma unroll
                    for (int hp = 0; hp < 2; ++hp) { const f32x2 ag = {acc[ai][0][m][n][2 * hp], acc[ai][0][m][n][2 * hp + 1]}, au = {acc[ai][1][m][n][2 * hp], acc[ai][1][m][n][2 * hp + 1]};
                        const f32x2 t = ag * rn; f32x2 e; e.x = __builtin_amdgcn_exp2f(t.x); e.y = __builtin_amdgcn_exp2f(t.y);
                        const f32x2 d = e + 1.0f; f32x2 sg; sg.x = __builtin_amdgcn_rcpf(d.x); sg.y = __builtin_amdgcn_rcpf(d.y);
                        const f32x2 hh = (ag * au) * (sg * rr);
                        h[4 * n + 2 * hp] = hh.x; h[4 * n + 2 * hp + 1] = hh.y; }
                u32x4 w; w.x = cvt_pk_bf16(h[0], h[1]); w.y = cvt_pk_bf16(h[2], h[3]); w.z = cvt_pk_bf16(h[4], h[5]); w.w = cvt_pk_bf16(h[6], h[7]);
                *(u32x4*)(O + (size_t)(row0 + ai * HALF + m * 16) * ldc + col0) = w; }
    }
};
struct EpiResid2 {
    static constexpr bool PERM = true, AFTER_DRAIN = false;
    const float* base; float* out; bf16_t* HB; float* S; int ldc; float scale;
    __device__ __forceinline__ void operator()(const f32x4 (&acc)[2][2][4][2], const Unit& u, int wr, int wc, int fr, int fq) const {
        const int col0 = u.pn * BM + wc * 32 + 8 * fq, lane = fr + 16 * fq;
#pragma unroll
        for (int ai = 0; ai < 2; ++ai)
#pragma unroll
            for (int m = 0; m < 4; ++m) { const int row = u.pm * BM + ai * HALF + wr * 64 + m * 16 + fr; const size_t off = (size_t)row * ldc + col0; float ss = 0.f;
#pragma unroll
                for (int bj = 0; bj < 2; ++bj) { const f32x4 b0 = *(const f32x4*)(base + off + bj * HALF), b1 = *(const f32x4*)(base + off + bj * HALF + 4);
                    const f32x4 v0 = b0 + acc[ai][bj][m][0] * scale, v1 = b1 + acc[ai][bj][m][1] * scale;
                    *(f32x4*)(out + off + bj * HALF) = v0; *(f32x4*)(out + off + bj * HALF + 4) = v1;
                    ss += (v0.x * v0.x + v0.y * v0.y) + (v0.z * v0.z + v0.w * v0.w) + (v1.x * v1.x + v1.y * v1.y) + (v1.z * v1.z + v1.w * v1.w);
                    u32x4 w; w.x = cvt_pk_bf16(v0.x, v0.y); w.y = cvt_pk_bf16(v0.z, v0.w); w.z = cvt_pk_bf16(v1.x, v1.y); w.w = cvt_pk_bf16(v1.z, v1.w); *(u32x4*)(HB + off + bj * HALF) = w; }
                ss += bperm_f(lane ^ 16, ss); ss += bperm_f(lane ^ 32, ss);
                if (fq == 0) S[(size_t)row * 32 + 4 * u.pn + wc] = ss;
                asm volatile("" ::: "memory"); }
    }
};
struct EpiResid3 {
    static constexpr bool PERM = true, AFTER_DRAIN = false;
    bf16_t* HB; bf16_t* LO; float* S; int ldc; float scale;
    static __device__ __forceinline__ float lo16(unsigned u) { return __builtin_bit_cast(float, u << 16); }
    static __device__ __forceinline__ float hi16(unsigned u) { return __builtin_bit_cast(float, u & 0xffff0000u); }
    __device__ __forceinline__ void operator()(const f32x4 (&acc)[2][2][4][2], const Unit& u, int wr, int wc, int fr, int fq) const {
        const int col0 = u.pn * BM + wc * 32 + 8 * fq, lane = fr + 16 * fq;
#pragma unroll
        for (int ai = 0; ai < 2; ++ai)
#pragma unroll
            for (int m = 0; m < 4; ++m) { const int row = u.pm * BM + ai * HALF + wr * 64 + m * 16 + fr; const size_t off = (size_t)row * ldc + col0; float ss = 0.f;
#pragma unroll
                for (int bj = 0; bj < 2; ++bj) { const u32x4 h = *(const u32x4*)(HB + off + bj * HALF); u32x4 l = {0u, 0u, 0u, 0u}; if (LO) l = *(const u32x4*)(LO + off + bj * HALF);
                    float v[8];
#pragma unroll
                    for (int i = 0; i < 4; ++i) { v[2 * i] = (lo16(h[i]) + lo16(l[i])) + acc[ai][bj][m][i >> 1][(2 * i) & 3] * scale; v[2 * i + 1] = (hi16(h[i]) + hi16(l[i])) + acc[ai][bj][m][i >> 1][(2 * i + 1) & 3] * scale; }
                    u32x4 wh, wl;
#pragma unroll
                    for (int i = 0; i < 4; ++i) { ss += v[2 * i] * v[2 * i] + v[2 * i + 1] * v[2 * i + 1]; const unsigned p = cvt_pk_bf16(v[2 * i], v[2 * i + 1]); wh[i] = p;
                        wl[i] = cvt_pk_bf16(v[2 * i] - lo16(p), v[2 * i + 1] - hi16(p)); }
                    *(u32x4*)(HB + off + bj * HALF) = wh; if (LO) *(u32x4*)(LO + off + bj * HALF) = wl; }
                ss += bperm_f(lane ^ 16, ss); ss += bperm_f(lane ^ 32, ss);
                if (fq == 0) S[(size_t)row * 32 + 4 * u.pn + wc] = ss;
                asm volatile("" ::: "memory"); }
    }
};
__host__ __device__ __forceinline__ int rope_perm64(int c) { return ((c >> 5) & 1) * 128 + (c >> 6) * 32 + (c & 31); }
__host__ __device__ __forceinline__ int rope_perm128(int c) { return ((c >> 6) & 1) * 128 + (c >> 7) * 64 + (c & 63); }
__host__ __device__ __forceinline__ int win_kind(int t) { return t < 4 ? 2 : t < 6 ? 0 : t < 10 ? 1 : t == 10 ? 2 : t < 17 ? 3 : 0; }
template <int NPART> struct EpiMix {
    static constexpr bool PERM = true, AFTER_DRAIN = false;
    bf16_t* O; int ldc; const float* S; float inv_n; int mode;
    const float* cos64; const float* sin64; const float* cos128; const float* sin128; float* SQ; float* SKV; RstdCache rc; float osc;
    __device__ __forceinline__ void operator()(const f32x4 (&acc)[2][2][4][2], const Unit& u, int wr, int wc, int fr, int fq) const {
        float rs[2][4]; rstd8_cached<NPART>(rc, S, u, wr, fr, fq, inv_n, 1e-6f, rs);
        const float osc_ = (mode == 0) ? ((PRESC_DIFF != 0 && u.pn < 2) ? QS_DIFF : (PRESC_DIL != 0 && u.pn >= 11 && u.pn <= 13) ? QS_DIL : 1.0f) : osc;
        const int kind = (mode == 0) ? win_kind(u.pn) : (mode == 1) ? (u.pn < 3 ? 0 : 2) : 0;
        const int row0 = u.pm * BM + wr * 64 + fr, lane = fr + 16 * fq;
        if (kind < 2) {
            const int col0 = u.pn * BM + wc * 32 + 8 * fq;
#pragma unroll
            for (int ai = 0; ai < 2; ++ai)
#pragma unroll
                for (int m = 0; m < 4; ++m) { const int row = row0 + ai * HALF + m * 16; const float r = rs[ai][m] * osc_; float ss = 0.f;
#pragma unroll
                    for (int bj = 0; bj < 2; ++bj) { const f32x4 v0 = acc[ai][bj][m][0] * r, v1 = acc[ai][bj][m][1] * r;
                        ss += (v0[0] * v0[0] + v0[1] * v0[1]) + (v0[2] * v0[2] + v0[3] * v0[3]) + (v1[0] * v1[0] + v1[1] * v1[1]) + (v1[2] * v1[2] + v1[3] * v1[3]);
                        u32x4 w; w.x = cvt_pk_bf16(v0[0], v0[1]); w.y = cvt_pk_bf16(v0[2], v0[3]); w.z = cvt_pk_bf16(v1[0], v1[1]); w.w = cvt_pk_bf16(v1[2], v1[3]);
                        *(u32x4*)(O + (size_t)row * ldc + col0 + bj * HALF) = w; }
                    if (kind == 1) { ss += bperm_f(lane ^ 16, ss); ss += bperm_f(lane ^ 32, ss);
                        if (fq == 0) { float* dst = (u.pn < 8) ? SQ : SKV; dst[(size_t)row * 8 + 4 * (u.pn & 1) + wc] = ss; } } }
        } else {
            const bool r64 = (kind == 2);
            const int hd = r64 ? wc : (wc >> 1), idx = r64 ? 8 * fq : 32 * (wc & 1) + 8 * fq, hw = r64 ? 64 : 128, tw = r64 ? 32 : 64;
            const float* ct = r64 ? cos64 : cos128; const float* st = r64 ? sin64 : sin128;
            const int colb = u.pn * BM + hd * hw + idx;
#pragma unroll
            for (int ai = 0; ai < 2; ++ai)
#pragma unroll
                for (int m = 0; m < 4; ++m) { const int row = row0 + ai * HALF + m * 16; const float r = rs[ai][m] * osc_;
                    const f32x4 c0 = *(const f32x4*)(ct + (size_t)row * tw + idx), c1 = *(const f32x4*)(ct + (size_t)row * tw + idx + 4);
                    const f32x4 s0 = *(const f32x4*)(st + (size_t)row * tw + idx), s1 = *(const f32x4*)(st + (size_t)row * tw + idx + 4);
                    const f32x4 a0 = acc[ai][0][m][0] * r, a1 = acc[ai][0][m][1] * r, b0 = acc[ai][1][m][0] * r, b1 = acc[ai][1][m][1] * r;
                    const f32x4 y10 = a0 * c0 - b0 * s0, y11 = a1 * c1 - b1 * s1, y20 = a0 * s0 + b0 * c0, y21 = a1 * s1 + b1 * c1;
                    u32x4 w1, w2; w1.x = cvt_pk_bf16(y10[0], y10[1]); w1.y = cvt_pk_bf16(y10[2], y10[3]); w1.z = cvt_pk_bf16(y11[0], y11[1]); w1.w = cvt_pk_bf16(y11[2], y11[3]);
                    w2.x = cvt_pk_bf16(y20[0], y20[1]); w2.y = cvt_pk_bf16(y20[2], y20[3]); w2.z = cvt_pk_bf16(y21[0], y21[1]); w2.w = cvt_pk_bf16(y21[2], y21[3]);
                    *(u32x4*)(O + (size_t)row * ldc + colb) = w1; *(u32x4*)(O + (size_t)row * ldc + colb + hw / 2) = w2; }
        }
    }
};

template <class Epi, class Sched, bool ALIGN_EPI = false, bool SP2 = false>
__device__ __forceinline__ void gemm_phase(PG8_LAS unsigned char* lds, const Gemm g, const Sched& S, const Epi& E, const int tid  ) {
    const int wid = __builtin_amdgcn_readfirstlane(tid >> 6), lane = tid & 63, wr = wid >> 2, wc = wid & 3, fr = lane & 15, fq = lane >> 4;
    const int K = g.K, nt = K / BK;
    unsigned voffA[2], voffB[2];
#pragma unroll
    for (int i = 0; i < 2; ++i) { int R, C; stage_rc(tid * 16 + i * 8192, R, C); const int Rb = Epi::PERM ? ((R & ~31) + perm32(R & 31)) : R;
        voffA[i] = (unsigned)(R * g.lda + C) * 2u; voffB[i] = (unsigned)(Rb * g.ldb + C) * 2u; }
    const size_t kstep = (size_t)(BK * 2);
    const size_t hstepA = (size_t)HALF * g.lda * 2, hstepB = (size_t)HALF * g.ldb * 2;
    const size_t tstepA = 2 * hstepA, tstepB = 2 * hstepB;
    const unsigned ldsw = (unsigned)wid * 1024u;
    const int aoff = lds_byte(wr * 64 + fr, fq * 8), boff = lds_byte(wc * 32 + fr, fq * 8);
#define PG8_SA(b, h) (((b) * 2 + (h)) * HTB)
#define PG8_SB(b, h) ((4 + (b) * 2 + (h)) * HTB)
#define PG8_STAGE(bufoff, gbase, voff) do { _Pragma("unroll") for (int _i = 0; _i < 2; ++_i) \
        __builtin_amdgcn_global_load_lds((const unsigned*)((const char*)(gbase) + (voff)[_i]), (PG8_LAS unsigned*)(lds + (bufoff) + ldsw + _i * 8192), 16, 0, 0); } while (0)
#define PG8_LDA(dst, b, h) do { _Pragma("unroll") for (int m = 0; m < 4; ++m) _Pragma("unroll") for (int k = 0; k < 2; ++k) dst[m][k] = *(const PG8_LAS bf16x8*)(lds + PG8_SA(b, h) + aoff + m * 2048 + k * 1024); } while (0)
#define PG8_LDB(dst, b, h) do { _Pragma("unroll") for (int n = 0; n < 2; ++n) _Pragma("unroll") for (int k = 0; k < 2; ++k) dst[n][k] = *(const PG8_LAS bf16x8*)(lds + PG8_SB(b, h) + boff + n * 2048 + k * 1024); } while (0)
#define PG8_MMA(ai, bj, At, Bt) do { __builtin_amdgcn_s_setprio(1); _Pragma("unroll") for (int m = 0; m < 4; ++m) _Pragma("unroll") for (int n = 0; n < 2; ++n) _Pragma("unroll") for (int k = 0; k < 2; ++k) \
        acc[ai][bj][m][n] = __builtin_amdgcn_mfma_f32_16x16x32_bf16(Bt[n][k], At[m][k], acc[ai][bj][m][n], 0, 0, 0); __builtin_amdgcn_s_setprio(0); } while (0)
#define PG8_WAIT_V(n) asm volatile("s_waitcnt vmcnt(" #n ")" ::: "memory")
#define PG8_WAIT_L(n) asm volatile("s_waitcnt lgkmcnt(" #n ")" ::: "memory")
#define PG8_BAR __builtin_amdgcn_s_barrier()
#define PG8_SCHED __builtin_amdgcn_sched_barrier(0)
    Unit cur, nxt; int ui = 0;
    if (!S.next(0, cur)) return;
    f32x4 acc[2][2][4][2];
#pragma unroll
    for (int a = 0; a < 2; ++a)
#pragma unroll
        for (int b = 0; b < 2; ++b)
#pragma unroll
            for (int m = 0; m < 4; ++m)
#pragma unroll
                for (int n = 0; n < 2; ++n) acc[a][b][m][n] = (f32x4){0.f, 0.f, 0.f, 0.f};
    bf16x8 At[4][2], B0[2][2], B1[2][2];
    const char* cA = (const char*)g.A + (size_t)cur.pm * tstepA; const char* cB = (const char*)g.Bt + (size_t)cur.pn * tstepB;
    S.a_ready(cur);
    if constexpr (SP2) {
        PG8_STAGE(PG8_SB(0, 0), cB, voffB); PG8_STAGE(PG8_SB(0, 1), cB + hstepB, voffB); PG8_STAGE(PG8_SA(0, 0), cA, voffA); PG8_STAGE(PG8_SA(0, 1), cA + hstepA, voffA);
        if (wr == 1) PG8_BAR;
        PG8_WAIT_V(2); PG8_BAR;
        PG8_STAGE(PG8_SB(1, 0), cB + kstep, voffB); PG8_STAGE(PG8_SA(1, 0), cA + kstep, voffA); PG8_STAGE(PG8_SB(1, 1), cB + hstepB + kstep, voffB);
        PG8_WAIT_V(6); PG8_BAR;
    } else {
        PG8_STAGE(PG8_SB(0, 0), cB, voffB); PG8_STAGE(PG8_SA(0, 0), cA, voffA); PG8_STAGE(PG8_SB(0, 1), cB + hstepB, voffB); PG8_STAGE(PG8_SA(0, 1), cA + hstepA, voffA);
        if (wr == 1) PG8_BAR;
        PG8_WAIT_V(4); PG8_BAR;
        PG8_STAGE(PG8_SB(1, 0), cB + kstep, voffB); PG8_STAGE(PG8_SA(1, 0), cA + kstep, voffA); PG8_STAGE(PG8_SB(1, 1), cB + hstepB + kstep, voffB);
        PG8_WAIT_V(6); PG8_BAR;
    }
    for (;;) {
        const bool has_next = S.next(ui + 1, nxt);
        const char* nA = has_next ? (const char*)g.A + (size_t)nxt.pm * tstepA : cA; const char* nB = has_next ? (const char*)g.Bt + (size_t)nxt.pn * tstepB : cB;
        for (int t = 0; t < nt; t += 2) {
            const bool last = (t == nt - 2);
            const char* a1 = cA + (size_t)(t + 1) * kstep;
            const char* a2 = last ? nA : cA + (size_t)(t + 2) * kstep; const char* b2 = last ? nB : cB + (size_t)(t + 2) * kstep;
            const char* a3 = a2 + kstep; const char* b3 = b2 + kstep;
            if (last && has_next) S.a_ready(nxt);
            if constexpr (SP2) {
            PG8_LDB(B0, 0, 0); PG8_LDB(B1, 0, 1); PG8_SCHED; PG8_LDA(At, 0, 0); PG8_STAGE(PG8_SA(1, 1), a1 + hstepA, voffA);
            PG8_WAIT_V(8); PG8_WAIT_L(0); PG8_BAR; PG8_MMA(0, 0, At, B0); PG8_MMA(0, 1, At, B1); PG8_BAR; PG8_SCHED;
            PG8_LDA(At, 0, 1); PG8_STAGE(PG8_SB(0, 0), b2, voffB); PG8_STAGE(PG8_SB(0, 1), b2 + hstepB, voffB); PG8_STAGE(PG8_SA(0, 0), a2, voffA);
            PG8_WAIT_V(8); PG8_WAIT_L(0); PG8_BAR; PG8_MMA(1, 0, At, B0); PG8_MMA(1, 1, At, B1); PG8_BAR; PG8_SCHED;
            PG8_LDB(B0, 1, 0); PG8_LDB(B1, 1, 1); PG8_SCHED; PG8_LDA(At, 1, 0); PG8_STAGE(PG8_SA(0, 1), a2 + hstepA, voffA);
            PG8_WAIT_V(8); PG8_WAIT_L(0); PG8_BAR; PG8_MMA(0, 0, At, B0); PG8_MMA(0, 1, At, B1); PG8_BAR; PG8_SCHED;
            PG8_LDA(At, 1, 1); PG8_STAGE(PG8_SB(1, 0), b3, voffB); PG8_STAGE(PG8_SB(1, 1), b3 + hstepB, voffB); PG8_STAGE(PG8_SA(1, 0), a3, voffA);
            PG8_WAIT_V(8); PG8_WAIT_L(0); PG8_BAR; PG8_MMA(1, 0, At, B0); PG8_MMA(1, 1, At, B1); PG8_BAR; PG8_SCHED;
            } else {
            PG8_LDB(B0, 0, 0); PG8_SCHED; PG8_LDA(At, 0, 0); PG8_STAGE(PG8_SA(1, 1), a1 + hstepA, voffA);
            PG8_WAIT_L(8); PG8_BAR; PG8_WAIT_L(0); PG8_MMA(0, 0, At, B0); PG8_BAR; PG8_SCHED;
            PG8_LDB(B1, 0, 1); PG8_STAGE(PG8_SB(0, 0), b2, voffB);
            PG8_BAR; PG8_WAIT_L(0); PG8_MMA(0, 1, At, B1); PG8_BAR;
            PG8_LDA(At, 0, 1); PG8_STAGE(PG8_SA(0, 0), a2, voffA);
            PG8_BAR; PG8_WAIT_L(0); PG8_MMA(1, 0, At, B0); PG8_BAR; PG8_SCHED;
            PG8_STAGE(PG8_SB(0, 1), b2 + hstepB, voffB);
            PG8_WAIT_V(6); PG8_BAR; PG8_MMA(1, 1, At, B1); PG8_BAR;
            PG8_LDB(B0, 1, 0); PG8_SCHED; PG8_LDA(At, 1, 0); PG8_STAGE(PG8_SA(0, 1), a2 + hstepA, voffA);
            PG8_WAIT_L(8); PG8_BAR; PG8_WAIT_L(0); PG8_MMA(0, 0, At, B0); PG8_BAR; PG8_SCHED;
            PG8_LDB(B1, 1, 1); PG8_STAGE(PG8_SB(1, 0), b3, voffB);
            PG8_BAR; PG8_WAIT_L(0); PG8_MMA(0, 1, At, B1); PG8_BAR;
            PG8_LDA(At, 1, 1); PG8_STAGE(PG8_SA(1, 0), a3, voffA);
            PG8_BAR; PG8_WAIT_L(0); PG8_MMA(1, 0, At, B0); PG8_BAR; PG8_SCHED;
            PG8_STAGE(PG8_SB(1, 1), b3 + hstepB, voffB);
            PG8_WAIT_V(6); PG8_BAR; PG8_MMA(1, 1, At, B1); PG8_BAR;
            }
        }
        if constexpr (ALIGN_EPI) { if (wr == 0) PG8_BAR; }
        if constexpr (!Epi::AFTER_DRAIN) { E(acc, cur, wr, wc, fr, fq); S.done(cur); }
        if (!has_next) break;
#pragma unroll
        for (int a = 0; a < 2; ++a)
#pragma unroll
            for (int b = 0; b < 2; ++b)
#pragma unroll
                for (int m = 0; m < 4; ++m)
#pragma unroll
                    for (int n = 0; n < 2; ++n) acc[a][b][m][n] = (f32x4){0.f, 0.f, 0.f, 0.f};
        cur = nxt; cA = nA; cB = nB; ++ui;
        if constexpr (ALIGN_EPI) { if (wr == 1) PG8_BAR; }
    }
    PG8_WAIT_V(0);
    if constexpr (!ALIGN_EPI) { if (wr == 0) PG8_BAR; }
    PG8_BAR;
    if constexpr (Epi::AFTER_DRAIN) { E.fused(acc, cur, wr, wc, fr, fq, lds, wid, lane); S.done(cur); }
#undef PG8_SA
#undef PG8_SB
#undef PG8_STAGE
#undef PG8_LDA
#undef PG8_LDB
#undef PG8_MMA
#undef PG8_WAIT_V
#undef PG8_WAIT_L
#undef PG8_BAR
#undef PG8_SCHED
}
}

constexpr int NWAVES = 8;
constexpr int BATCH = 4, SEQ = 4096, DM = 2048, FF = 5632, DEPTH = 4, M = BATCH * SEQ;
constexpr int NIN = 4928, NINP = 5120;
constexpr int MEML = 256, MMEM = BATCH * MEML;
constexpr int UC_Q1 = 0, UC_Q2 = 256, UC_K1 = 512, UC_K2 = 768, UC_VA = 1024, UC_CQ = 1536, UC_CKV = 2048, UC_KR = 2560, UC_QC = 2816, UC_KC = 3584, UC_VC = 4352;
constexpr int NUQ = 1152, NUQP = 1280, NUKV = 1536;
constexpr size_t WO_GU1 = 0;
constexpr size_t WO_D1  = WO_GU1 + (size_t)2 * FF * DM;
constexpr size_t WO_IN  = WO_D1 + (size_t)DM * FF;
constexpr size_t WO_UQ  = WO_IN + (size_t)NINP * DM;
constexpr size_t WO_UKV = WO_UQ + (size_t)NUQP * 512;
constexpr size_t WO_OUT = WO_UKV + (size_t)NUKV * 512;
constexpr size_t WO_CQ  = WO_OUT + (size_t)DM * DM;
constexpr size_t WO_CKV = WO_CQ + (size_t)512 * DM;
constexpr size_t WO_CO  = WO_CKV + (size_t)1024 * DM;
constexpr size_t WO_GU2 = WO_CO + (size_t)DM * 512;
constexpr size_t WO_D2  = WO_GU2 + (size_t)2 * FF * DM;
constexpr size_t W_LAYER = WO_D2 + (size_t)DM * FF;
constexpr size_t MiB = 1u << 20;
constexpr size_t WS_CTL = 0, CTL_ZERO_BYTES = 256 * 1024;
constexpr size_t WS_COS64 = 1 * MiB, WS_SIN64 = 3 * MiB, WS_COS128 = 5 * MiB, WS_SIN128 = 9 * MiB;
constexpr size_t WS_LAM = WS_CTL + 524288, WS_MSTAT = WS_CTL + 589824;
constexpr size_t WS_SQ = 13 * MiB, WS_SKV = WS_SQ + 524288, WS_STATS = 14 * MiB;
constexpr size_t WS_W = 16 * MiB;
constexpr size_t WS_XN = 700 * MiB;
constexpr size_t WS_MEMB = 764 * MiB;
constexpr size_t WS_BIG = 768 * MiB;
constexpr size_t WS_U = WS_BIG;
constexpr size_t WS_QM = WS_U + (size_t)M * NINP * 2;
constexpr size_t WS_KVM = WS_QM + (size_t)M * NUQP * 2;
constexpr size_t WS_Y = WS_KVM + (size_t)M * NUKV * 2;
constexpr size_t WS_A1 = WS_Y + (size_t)M * DM * 2;
constexpr size_t WS_OD = WS_A1 + (size_t)M * 512 * 4;
constexpr size_t WS_LSE = WS_OD + (size_t)3 * M * 768 * 2;
constexpr size_t WS_CQ2 = WS_LSE + (size_t)3 * M * 8 * 4;
constexpr size_t WS_OC = WS_CQ2 + (size_t)M * 512 * 2;
constexpr size_t WS_KVC = WS_OC + (size_t)M * 512 * 2;
constexpr size_t WS_HID = WS_KVC + (size_t)MMEM * 1024 * 2;
constexpr size_t WS_LO = WS_HID + (size_t)M * FF * 2;
constexpr size_t WS_END = WS_LO + (size_t)M * DM * 2;
constexpr size_t WS_GU = WS_U, WS_CQN = WS_U, WS_CKVN = WS_U, WS_MEMN = WS_U;
static_assert(WS_END <= (size_t)1490 * MiB, "workspace: sum of the inputs is 1495 MiB");
constexpr int CW_BAR = 4096, CW_LBAR = 8192, CW_Q = 16384, CW_PBAR = 24576;
static_assert((size_t)(CW_PBAR + 4 * 3456) * 4 <= CTL_ZERO_BYTES && CTL_ZERO_BYTES <= 524288, "every barrier / queue word inside the per-call memset, the prologue's tables outside it");
constexpr int RING_OFF = 0, RING_BYTES = 131072;
constexpr int LDSCTL_OFF = RING_BYTES, MISC_OFF = LDSCTL_OFF + 320, RSTD_OFF = LDSCTL_OFF + 1024;
constexpr int LDS_BYTES = 147456;

#ifndef FA_DIFF
#define FA_DIFF 1
#endif
#ifndef FA_MLA
#define FA_MLA 1
#endif
#ifndef FA_DIL
#define FA_DIL 1
#endif
#ifndef FA_CROSS
#define FA_CROSS 1
#endif
#define GAS __attribute__((address_space(1)))
#define LAS __attribute__((address_space(3)))
typedef unsigned short bf16;
typedef unsigned v4u __attribute__((ext_vector_type(4)));
typedef float f32x4 __attribute__((ext_vector_type(4)));
typedef GAS unsigned gu32;
#define RLX_AGENT __ATOMIC_RELAXED, __HIP_MEMORY_SCOPE_AGENT
#define LDS_WAIT() asm volatile("s_waitcnt lgkmcnt(0)" ::: "memory")
#define VM_WAIT() asm volatile("s_waitcnt vmcnt(0)" ::: "memory")
__device__ __forceinline__ unsigned f2bf(float f) { unsigned u = __builtin_bit_cast(unsigned, f); return (u + 0x7fffu + ((u >> 16) & 1u)) >> 16; }
__device__ __forceinline__ unsigned pk2(float lo, float hi) { return f2bf(lo) | (f2bf(hi) << 16); }
__device__ __forceinline__ float bflo(unsigned u) { return __builtin_bit_cast(float, u << 16); }
__device__ __forceinline__ float bfhi(unsigned u) { return __builtin_bit_cast(float, u & 0xffff0000u); }
__device__ __forceinline__ float bf1(bf16 h) { return __builtin_bit_cast(float, (unsigned)h << 16); }

#define XB_TMO      128
#define XB_XCNT(j)  (256  + 64 * (j))
#define XB_XSUB(j)  (1280 + 64 * (j))
#define XB_XGEN(j)  (2304 + 64 * (j))
#define XB_TOP      3328
#define XB_TOPGEN   3392
#define XCD_BAR_WORDS 3456
#define XB_SPIN_CAP (1u << 18)

__device__ __forceinline__ unsigned xb_ld(unsigned* p)              { return __hip_atomic_load(p, __ATOMIC_RELAXED, __HIP_MEMORY_SCOPE_AGENT); }
__device__ __forceinline__ unsigned xb_add(unsigned* p, unsigned v) { return __hip_atomic_fetch_add(p, v, __ATOMIC_RELAXED, __HIP_MEMORY_SCOPE_AGENT); }
__device__ __forceinline__ unsigned xb_xcc_id() { return (unsigned)__builtin_amdgcn_s_getreg((3 << 11) | 20) & 0xFu; }
#define XB_SPIN(cond, bar) do { unsigned _sp = 0; while (cond) { __builtin_amdgcn_s_sleep(1); \
    if ((++_sp & 255u) == 0u) { if (xb_ld(&(bar)[XB_TMO])) break; if (_sp > XB_SPIN_CAP) { atomicAdd(&(bar)[XB_TMO], 1u); break; } } } } while (0)

struct XcdBarrier {
    unsigned* bar; unsigned x;
    volatile LAS unsigned* st;
};

__device__ __forceinline__ XcdBarrier xcd_barrier_post(unsigned* bar, volatile LAS unsigned* st) {
    XcdBarrier b; b.bar = bar; b.x = xb_xcc_id(); b.st = st;
    if (threadIdx.x == 0) (void)xb_add(&bar[XB_XCNT(b.x)], 1u);
    return b;
}
__device__ __forceinline__ void xcd_barrier_complete(unsigned* bar, unsigned x, unsigned& nloc, unsigned& nx) {
    const unsigned G = gridDim.x * gridDim.y * gridDim.z;
    unsigned sum, cnt, mine, sp = 0u;
    for (;;) {
        sum = 0u; cnt = 0u; mine = 0u;
#pragma unroll
        for (unsigned j = 0; j < 16; ++j) { const unsigned c = xb_ld(&bar[XB_XCNT(j)]); sum += c; cnt += (c > 0u) ? 1u : 0u; mine = (j == x) ? c : mine; }
        if (sum == G) break;
        __builtin_amdgcn_s_sleep(1);
        if ((++sp & 255u) == 0u) { if (xb_ld(&bar[XB_TMO])) break; if (sp > XB_SPIN_CAP) { atomicAdd(&bar[XB_TMO], 1u); break; } }
    }
    nloc = mine > 0u ? mine : 1u; nx = cnt > 0u ? cnt : 1u;
}

__device__ __forceinline__ void xcd_barrier(const XcdBarrier& b, const bool leader  ) {
    asm volatile("s_waitcnt vmcnt(0)" ::: "memory");
    __syncthreads();
    if (leader) {
        unsigned* bar = b.bar;
        __builtin_amdgcn_s_waitcnt(0);
        unsigned nloc = b.st[0], nx = b.st[1];
        if (nloc == 0u) { xcd_barrier_complete(bar, b.x, nloc, nx); b.st[0] = nloc; b.st[1] = nx; }
        const unsigned old = xb_add(&bar[XB_XSUB(b.x)], 1u);
        const unsigned gen = old / nloc;
        if (old + 1u == (gen + 1u) * nloc) {
            __builtin_amdgcn_fence(__ATOMIC_RELEASE, "agent");
            asm volatile("s_waitcnt vmcnt(0)" ::: "memory");
            const unsigned og = xb_add(&bar[XB_TOP], 1u);
            const unsigned tg = og / nx;
            if (og + 1u == (tg + 1u) * nx) xb_add(&bar[XB_TOPGEN], 1u);
            else XB_SPIN(xb_ld(&bar[XB_TOPGEN]) == tg, bar);
            __builtin_amdgcn_fence(__ATOMIC_ACQUIRE, "agent");
            xb_add(&bar[XB_XGEN(b.x)], 1u);
            asm volatile("s_waitcnt vmcnt(0)" ::: "memory");
        } else {
            XB_SPIN(xb_ld(&bar[XB_XGEN(b.x)]) == gen, bar);
            __builtin_amdgcn_fence(__ATOMIC_ACQUIRE, "agent");
            asm volatile("s_waitcnt vmcnt(0)" ::: "memory");
        }
    }
    __syncthreads();
}

struct Params {
    const float* in[26]; float* out; unsigned char* ws;
    float inv64[32]; float inv128[64]; float lam_init[4];
    int ph_lo, ph_hi, use_bar, pad;
};
enum InIdx { I_X = 0, I_MEM, I_POS, I_F1N, I_F1G, I_F1U, I_F1D, I_MIXN, I_WIN, I_DLAM, I_DSUB, I_QN, I_WUQ, I_KVN, I_WUKV, I_WOUT, I_CRN, I_MEMN, I_CWQ, I_CWKV, I_CWO, I_F2N, I_F2G, I_F2U, I_F2D, I_FINN };

__device__ __forceinline__ int fresh_lane() { int l; asm volatile("v_mbcnt_lo_u32_b32 %0, -1, 0\n\tv_mbcnt_hi_u32_b32 %0, -1, %0" : "=v"(l)); return l; }
__device__ __forceinline__ float lane_xor(float v, int lane, int o) { return __builtin_bit_cast(float, __builtin_amdgcn_ds_bpermute((lane ^ o) << 2, __builtin_bit_cast(int, v))); }
__device__ __forceinline__ float wave_sum(float v, int lane) {
#pragma unroll
    for (int o = 1; o < 64; o <<= 1) v += lane_xor(v, lane, o);
    return v;
}
__device__ __forceinline__ void transpose_item(const float* W, int K, int N, bf16* WT, int row_off, int split, int pad, LAS float* scr, int item, int lane) {
    const int nblk = N / 32, kb = item / nblk, nb = item % nblk, k0 = 64 * kb, n0 = 32 * nb;
#pragma unroll 8
    for (int i = 0; i < 32; ++i) { const int kk = 2 * i + (lane >> 5); scr[kk * 33 + (lane & 31)] = W[(size_t)(k0 + kk) * N + n0 + (lane & 31)]; }
    LDS_WAIT(); asm volatile("" ::: "memory");
    const int c = lane & 7;
#pragma unroll
    for (int j = 0; j < 4; ++j) { const int n = (lane >> 3) + 8 * j; const LAS float* s = scr + (8 * c) * 33 + n;
        v4u o; o.x = pk2(s[0 * 33], s[1 * 33]); o.y = pk2(s[2 * 33], s[3 * 33]); o.z = pk2(s[4 * 33], s[5 * 33]); o.w = pk2(s[6 * 33], s[7 * 33]);
        const int nn = n0 + n, dr = row_off + nn + (nn >= split ? pad : 0);
        *(GAS v4u*)(WT + (size_t)dr * K + k0 + 8 * c) = o; }
    LDS_WAIT(); asm volatile("" ::: "memory");
}
#define CONV(Wp, K_, N_, WTp, roff, split, pad) do { const int nit_ = ((K_) / 64) * ((N_) / 32); for (int it_ = gw; it_ < nit_; it_ += NGW) transpose_item((Wp), (K_), (N_), (WTp), (roff), (split), (pad), scr, it_, lane); } while (0)

__device__ __forceinline__ void sincos_rad(float ang, float& c, float& s) {
    double r = (double)ang * 0.15915494309189533577; r -= __builtin_floor(r); const float rf = (float)r;
    c = __builtin_amdgcn_cosf(rf); s = __builtin_amdgcn_sinf(rf);
}

__device__ __forceinline__ void nv_norm_rows(const float* src, const float* g, bf16* dst, int nrows, int gw, int NGW, int lane) {
    for (int m = gw; m < nrows; m += NGW) {
        const f32x4* xr = (const f32x4*)(src + (size_t)m * DM) + lane; const f32x4* gr = (const f32x4*)g + lane;
        f32x4 v[8]; float s = 0.f;
#pragma unroll
        for (int j = 0; j < 8; ++j) { v[j] = xr[64 * j]; s += (v[j].x * v[j].x + v[j].y * v[j].y) + (v[j].z * v[j].z + v[j].w * v[j].w); }
        const float rstd = 1.0f / sqrtf(wave_sum(s, lane) * (1.0f / DM) + 1e-6f);
        unsigned long long* o8 = (unsigned long long*)(dst + (size_t)m * DM) + lane;
#pragma unroll
        for (int j = 0; j < 8; ++j) { const f32x4 gg = gr[64 * j];
            o8[64 * j] = (unsigned long long)pk2(v[j].x * rstd * gg.x, v[j].y * rstd * gg.y) | ((unsigned long long)pk2(v[j].z * rstd * gg.z, v[j].w * rstd * gg.w) << 32); }
    }
}
__device__ __forceinline__ void nv_final_norm(float* h, const float* g, int gw, int NGW, int lane) {
    for (int m = gw; m < M; m += NGW) {
        f32x4* xr = (f32x4*)(h + (size_t)m * DM) + lane; const f32x4* gr = (const f32x4*)g + lane;
        f32x4 v[8]; float s = 0.f;
#pragma unroll
        for (int j = 0; j < 8; ++j) { v[j] = xr[64 * j]; s += (v[j].x * v[j].x + v[j].y * v[j].y) + (v[j].z * v[j].z + v[j].w * v[j].w); }
        const float rstd = 1.0f / sqrtf(wave_sum(s, lane) * (1.0f / DM) + 1e-6f);
#pragma unroll
        for (int j = 0; j < 8; ++j) { const f32x4 gg = gr[64 * j]; xr[64 * j] = (v[j] * rstd) * gg; }
    }
}
__device__ __forceinline__ void nv_swiglu(const bf16* GU, bf16* HID, int gtid, int gsize) {
    constexpr int C8 = FF / 8;
    for (int it = gtid; it < M * C8; it += gsize) { const int m = it / C8, j = (it % C8) * 8;
        const v4u g = *(const v4u*)(GU + (size_t)m * 2 * FF + j), u = *(const v4u*)(GU + (size_t)m * 2 * FF + FF + j);
        float gv[8] = {bflo(g.x), bfhi(g.x), bflo(g.y), bfhi(g.y), bflo(g.z), bfhi(g.z), bflo(g.w), bfhi(g.w)};
        float uv[8] = {bflo(u.x), bfhi(u.x), bflo(u.y), bfhi(u.y), bflo(u.z), bfhi(u.z), bflo(u.w), bfhi(u.w)};
        float r[8];
#pragma unroll
        for (int i = 0; i < 8; ++i) r[i] = gv[i] / (1.0f + __expf(-gv[i])) * uv[i];
        v4u o; o.x = pk2(r[0], r[1]); o.y = pk2(r[2], r[3]); o.z = pk2(r[4], r[5]); o.w = pk2(r[6], r[7]);
        *(v4u*)(HID + (size_t)m * FF + j) = o; }
}
__device__ __forceinline__ void nv_mix_post(bf16* U, const float* cos64, const float* sin64, const float* cos128, const float* sin128, const float* gq, const float* gkv, bf16* CQN, bf16* CKVN, int gw, int NGW, int lane) {
    for (int m = gw; m < M; m += NGW) {
        bf16* ur = U + (size_t)m * NINP;
        for (int p = lane; p < 1312; p += 64) {
            int c1, half; float cs, sn;
            if (p < 512) { const int i = p & 31; c1 = (p >> 5) * 64 + i; half = 32; cs = cos64[m * 32 + i]; sn = sin64[m * 32 + i]; }
            else if (p < 544) { const int i = p - 512; c1 = UC_KR + i; half = 32; cs = cos64[m * 32 + i]; sn = sin64[m * 32 + i]; }
            else { const int q = p - 544, i = q & 63; c1 = UC_QC + (q >> 6) * 128 + i; half = 64; cs = cos128[m * 64 + i]; sn = sin128[m * 64 + i]; }
            const float x1 = bf1(ur[c1]), x2 = bf1(ur[c1 + half]);
            ur[c1] = (bf16)f2bf(x1 * cs - x2 * sn); ur[c1 + half] = (bf16)f2bf(x1 * sn + x2 * cs);
        }
#pragma unroll
        for (int w = 0; w < 2; ++w) {
            const v4u x = *(const v4u*)(ur + (w ? UC_CKV : UC_CQ) + 8 * lane); const float* g = (w ? gkv : gq) + 8 * lane;
            float v[8] = {bflo(x.x), bfhi(x.x), bflo(x.y), bfhi(x.y), bflo(x.z), bfhi(x.z), bflo(x.w), bfhi(x.w)}; float s = 0.f;
#pragma unroll
            for (int i = 0; i < 8; ++i) s += v[i] * v[i];
            const float rstd = 1.0f / sqrtf(wave_sum(s, lane) * (1.0f / 512.0f) + 1e-6f);
            v4u o; o.x = pk2(v[0] * rstd * g[0], v[1] * rstd * g[1]); o.y = pk2(v[2] * rstd * g[2], v[3] * rstd * g[3]); o.z = pk2(v[4] * rstd * g[4], v[5] * rstd * g[5]); o.w = pk2(v[6] * rstd * g[6], v[7] * rstd * g[7]);
            *(v4u*)((w ? CKVN : CQN) + (size_t)m * 512 + 8 * lane) = o;
        }
    }
}
__device__ __forceinline__ void nv_mla_post(bf16* QM, const float* cos64, const float* sin64, int gw, int NGW, int lane) {
    for (int m = gw; m < M; m += NGW) {
        bf16* qr = QM + (size_t)m * NUQP;
        for (int p = lane; p < 192; p += 64) { const int i = p & 31, c1 = (p >> 5) * 192 + 128 + i; const float cs = cos64[m * 32 + i], sn = sin64[m * 32 + i];
            const float x1 = bf1(qr[c1]), x2 = bf1(qr[c1 + 32]); qr[c1] = (bf16)f2bf(x1 * cs - x2 * sn); qr[c1 + 32] = (bf16)f2bf(x1 * sn + x2 * cs); }
    }
}
struct NvState { float m, l; float o[32]; };
__device__ __forceinline__ void nv_init(NvState& st) { st.m = -INFINITY; st.l = 0.f;
#pragma unroll
    for (int d = 0; d < 32; ++d) st.o[d] = 0.f; }
template <int NP> __device__ __forceinline__ void nv_loadq(unsigned (&q)[NP], const bf16* p) {
#pragma unroll
    for (int i = 0; i < NP / 4; ++i) { const v4u x = *(const v4u*)(p + 8 * i); q[4 * i] = x.x; q[4 * i + 1] = x.y; q[4 * i + 2] = x.z; q[4 * i + 3] = x.w; } }
template <int NP> __device__ __forceinline__ float nv_dot(const unsigned (&q)[NP], const bf16* k) {
    float s = 0.f;
#pragma unroll
    for (int i = 0; i < NP / 4; ++i) { const v4u x = *(const v4u*)(k + 8 * i);
        s += bflo(q[4 * i]) * bflo(x.x) + bfhi(q[4 * i]) * bfhi(x.x) + bflo(q[4 * i + 1]) * bflo(x.y) + bfhi(q[4 * i + 1]) * bfhi(x.y)
           + bflo(q[4 * i + 2]) * bflo(x.z) + bfhi(q[4 * i + 2]) * bfhi(x.z) + bflo(q[4 * i + 3]) * bflo(x.w) + bfhi(q[4 * i + 3]) * bfhi(x.w); }
    return s; }
__device__ __forceinline__ float quad_sum(float v, int lane) { v += lane_xor(v, lane, 1); v += lane_xor(v, lane, 2); return v; }
__device__ __forceinline__ void nv_upd(NvState& st, float s, const bf16* v) {
    const float mn = fmaxf(st.m, s), a = __expf(st.m - mn), p = __expf(s - mn); st.m = mn; st.l = st.l * a + p;
#pragma unroll
    for (int i = 0; i < 4; ++i) { const v4u x = *(const v4u*)(v + 8 * i);
        st.o[8 * i + 0] = st.o[8 * i + 0] * a + p * bflo(x.x); st.o[8 * i + 1] = st.o[8 * i + 1] * a + p * bfhi(x.x); st.o[8 * i + 2] = st.o[8 * i + 2] * a + p * bflo(x.y); st.o[8 * i + 3] = st.o[8 * i + 3] * a + p * bfhi(x.y);
        st.o[8 * i + 4] = st.o[8 * i + 4] * a + p * bflo(x.z); st.o[8 * i + 5] = st.o[8 * i + 5] * a + p * bfhi(x.z); st.o[8 * i + 6] = st.o[8 * i + 6] * a + p * bflo(x.w); st.o[8 * i + 7] = st.o[8 * i + 7] * a + p * bfhi(x.w); }
}
__device__ __forceinline__ void nv_store(bf16* dst, const float (&o)[32], float sc) {
#pragma unroll
    for (int i = 0; i < 4; ++i) { v4u w; w.x = pk2(o[8 * i] * sc, o[8 * i + 1] * sc); w.y = pk2(o[8 * i + 2] * sc, o[8 * i + 3] * sc); w.z = pk2(o[8 * i + 4] * sc, o[8 * i + 5] * sc); w.w = pk2(o[8 * i + 6] * sc, o[8 * i + 7] * sc);
        *(v4u*)(dst + 8 * i) = w; } }
__device__ __forceinline__ void nv_attn_diff(const bf16* U, bf16* Y, const float* subln, float lam, float lam_init, int gtid, int gsize, int lane) {
    for (int task = gtid; task < M * 4 * 4; task += gsize) {
        const int qt = task & 3, idx = task >> 2, h = idx / M, m = idx % M, b = m / SEQ, s = m % SEQ;
        const bf16* qrow = U + (size_t)m * NINP; unsigned q1[8], q2[8];
        nv_loadq<8>(q1, qrow + UC_Q1 + h * 64 + qt * 16); nv_loadq<8>(q2, qrow + UC_Q2 + h * 64 + qt * 16);
        NvState a1, a2; nv_init(a1); nv_init(a2);
        const bf16* kb = U + (size_t)(b * SEQ) * NINP;
        for (int j = 0; j <= s; ++j) { const bf16* kr = kb + (size_t)j * NINP;
            const float s1 = quad_sum(nv_dot<8>(q1, kr + UC_K1 + h * 64 + qt * 16), lane) * 0.125f, s2 = quad_sum(nv_dot<8>(q2, kr + UC_K2 + h * 64 + qt * 16), lane) * 0.125f;
            const bf16* v = kr + UC_VA + h * 128 + qt * 32; nv_upd(a1, s1, v); nv_upd(a2, s2, v); }
        const float i1 = 1.0f / a1.l, i2 = lam / a2.l; float ss = 0.f;
#pragma unroll
        for (int d = 0; d < 32; ++d) { a1.o[d] = a1.o[d] * i1 - a2.o[d] * i2; ss += a1.o[d] * a1.o[d]; }
        ss = quad_sum(ss, lane);
        const float rstd = (1.0f / sqrtf(ss * (1.0f / 128.0f) + 1e-5f)) * (1.0f - lam_init);
#pragma unroll
        for (int d = 0; d < 32; ++d) a1.o[d] *= subln[qt * 32 + d];
        nv_store(Y + (size_t)m * DM + h * 128 + qt * 32, a1.o, rstd);
    }
}
__device__ __forceinline__ void nv_attn_mla(const bf16* QM, int qn0, int qns, int qr0, int qrs, const bf16* KVM, const bf16* U, bf16* Y, int gtid, int gsize, int lane) {
    for (int task = gtid; task < M * 6 * 4; task += gsize) {
        const int qt = task & 3, idx = task >> 2, h = idx / M, m = idx % M, b = m / SEQ, s = m % SEQ;
        unsigned qn[16], qr[8]; nv_loadq<16>(qn, QM + (size_t)m * NUQP + qn0 + h * qns + qt * 32); nv_loadq<8>(qr, QM + (size_t)m * NUQP + qr0 + h * qrs + qt * 16);
        NvState a; nv_init(a);
        for (int j = 0; j <= s; ++j) { const size_t kr = (size_t)(b * SEQ + j);
            const float sc = quad_sum(nv_dot<16>(qn, KVM + kr * NUKV + h * 256 + qt * 32) + nv_dot<8>(qr, U + kr * NINP + UC_KR + qt * 16), lane) * 0.07216878364870322f;
            nv_upd(a, sc, KVM + kr * NUKV + h * 256 + 128 + qt * 32); }
        nv_store(Y + (size_t)m * DM + 512 + h * 128 + qt * 32, a.o, 1.0f / a.l);
    }
}
__device__ __forceinline__ void nv_attn_dil(const bf16* U, bf16* Y, int gtid, int gsize, int lane) {
    for (int task = gtid; task < M * 6 * 4; task += gsize) {
        const int qt = task & 3, idx = task >> 2, h = idx / M, m = idx % M, b = m / SEQ, s = m % SEQ;
        unsigned q[16]; nv_loadq<16>(q, U + (size_t)m * NINP + UC_QC + h * 128 + qt * 32);
        NvState a; nv_init(a);
        for (int p = 0; p < 3; ++p) { const int dil = (p == 0) ? 1 : (p == 1) ? 4 : 16;
            for (int j = 0; j <= 128; ++j) { const int kj = s - j * dil; if (kj < 0) break;
                const bf16* kr = U + (size_t)(b * SEQ + kj) * NINP;
                const float sc = quad_sum(nv_dot<16>(q, kr + UC_KC + h * 128 + qt * 32), lane) * 0.08838834764831845f;
                nv_upd(a, sc, kr + UC_VC + h * 128 + qt * 32); } }
        nv_store(Y + (size_t)m * DM + 1280 + h * 128 + qt * 32, a.o, 1.0f / a.l);
    }
}
__device__ __forceinline__ void nv_attn_cross(const bf16* CQ2, const bf16* KVC, bf16* OC, int gtid, int gsize, int lane) {
    for (int task = gtid; task < M * 4 * 4; task += gsize) {
        const int qt = task & 3, idx = task >> 2, h = idx / M, m = idx % M, b = m / SEQ;
        unsigned q[16]; nv_loadq<16>(q, CQ2 + (size_t)m * 512 + h * 128 + qt * 32);
        NvState a; nv_init(a);
        for (int j = 0; j < MEML; ++j) { const bf16* kr = KVC + (size_t)(b * MEML + j) * 1024;
            const float sc = quad_sum(nv_dot<16>(q, kr + h * 128 + qt * 32), lane) * 0.08838834764831845f;
            nv_upd(a, sc, kr + 512 + h * 128 + qt * 32); }
        nv_store(OC + (size_t)m * 512 + h * 128 + qt * 32, a.o, 1.0f / a.l);
    }
}

#ifndef PVP64
#define PVP64 1
#endif
#ifndef PVP128M
#define PVP128M 0
#endif
#ifndef PVP128U
#define PVP128U 1
#endif
#ifndef PVPIPE_SB
#define PVPIPE_SB 1
#endif
#define PVPIPE_BODY(DK, MASKED) ((DK) == 64 ? (PVP64 != 0) : (MASKED) ? (PVP128M != 0) : (PVP128U != 0))
#ifndef PVX
#define PVX 1
#endif
#ifndef DMA_DIFF
#define DMA_DIFF 1
#endif
#ifndef DMA_DIL
#define DMA_DIL 1
#endif
#ifndef DMA_CROSS
#define DMA_CROSS 1
#endif
namespace fa {
typedef short bf16x8 __attribute__((ext_vector_type(8)));
typedef short s16x4 __attribute__((ext_vector_type(4)));
typedef float f32x16 __attribute__((ext_vector_type(16)));
typedef unsigned u32x4 __attribute__((ext_vector_type(4)));
constexpr int KVBLK = 64, QBLK = 32;
constexpr int SHM_V = KVBLK * 128 * 2;
#define FA_SBAR() __builtin_amdgcn_sched_barrier(0)
__device__ __forceinline__ int crow(int r, int hi) { return (r & 3) + 8 * (r >> 2) + 4 * hi; }
__device__ __forceinline__ unsigned cvtpk(float lo, float hi) { unsigned r; asm volatile("v_cvt_pk_bf16_f32 %0, %1, %2" : "=v"(r) : "v"(lo), "v"(hi)); return r; }
struct Desc {
    const bf16* q0; const bf16* q1; int qstride;
    const bf16* k0; int k0stride; const bf16* k1; int k1stride;
    const bf16* v; int vstride;
    int t0, t1;
    int qpos0, band;
};
__device__ __forceinline__ void partialSM(f32x16& p0, f32x16& p1, float& m_reg, float& mn, float& alpha, const float C, const float thrs) {
    float pmax = p0[0];
#pragma unroll
    for (int r = 1; r < 16; ++r) pmax = fmaxf(pmax, p0[r]);
#pragma unroll
    for (int r = 0; r < 16; ++r) pmax = fmaxf(pmax, p1[r]);
    { auto rr = __builtin_amdgcn_permlane32_swap(__float_as_uint(pmax), __float_as_uint(pmax), false, false); pmax = fmaxf(__uint_as_float(rr[0]), __uint_as_float(rr[1])); }
    if (__builtin_expect(__all(pmax - m_reg <= thrs), 1)) { mn = m_reg; alpha = 1.f; }
    else { mn = fmaxf(m_reg, pmax); alpha = __builtin_amdgcn_exp2f((m_reg - mn) * C); m_reg = mn; }
    const float mnC = -mn * C;
#pragma unroll
    for (int r = 0; r < 16; ++r) p0[r] = fmaf(p0[r], C, mnC);
#pragma unroll
    for (int r = 0; r < 16; ++r) p1[r] = fmaf(p1[r], C, mnC);
#pragma unroll
    for (int r = 0; r < 16; ++r) p0[r] = __builtin_amdgcn_exp2f(p0[r]);
}
__device__ __forceinline__ void finishSM(f32x16& p0, f32x16& p1, float alpha, float& l_reg, bf16x8& pa0, bf16x8& pa1, bf16x8& pa2, bf16x8& pa3) {
#pragma unroll
    for (int r = 0; r < 16; ++r) p1[r] = __builtin_amdgcn_exp2f(p1[r]);
    float ps = 0;
#pragma unroll
    for (int r = 0; r < 16; ++r) ps += p0[r];
#pragma unroll
    for (int r = 0; r < 16; ++r) ps += p1[r];
    { auto rr = __builtin_amdgcn_permlane32_swap(__float_as_uint(ps), __float_as_uint(ps), false, false); ps = __uint_as_float(rr[0]) + __uint_as_float(rr[1]); }
    l_reg = l_reg * alpha + ps;
#define FA_PK4(P, BASE, OUT) do { unsigned a0 = cvtpk(P[BASE + 0], P[BASE + 1]), a1 = cvtpk(P[BASE + 2], P[BASE + 3]);   \
    unsigned b0 = cvtpk(P[BASE + 4], P[BASE + 5]), b1 = cvtpk(P[BASE + 6], P[BASE + 7]);                              \
    auto r0 = __builtin_amdgcn_permlane32_swap(a0, b0, false, false); auto r1 = __builtin_amdgcn_permlane32_swap(a1, b1, false, false); \
    u32x4 w = {r0[0], r1[0], r0[1], r1[1]}; OUT = __builtin_bit_cast(bf16x8, w); } while (0)
    FA_PK4(p0, 0, pa0); FA_PK4(p0, 8, pa1); FA_PK4(p1, 0, pa2); FA_PK4(p1, 8, pa3);
#undef FA_PK4
}
template <int DK> __device__ __forceinline__ int kswz(int row, int colB) { return row * (DK * 2) + (colB ^ ((row & 7) << 4)); }
template <int DK> __device__ __forceinline__ void qkt(f32x16& p0, f32x16& p1, const char* Ks, const bf16x8* qr, int r32, int hi) {
    p0 = f32x16{}; p1 = f32x16{};
#pragma unroll
    for (int d0 = 0; d0 < DK / 16; ++d0) { const int cb = (d0 * 16 + hi * 8) * 2;
        const bf16x8 b0 = *reinterpret_cast<const bf16x8*>(Ks + kswz<DK>(r32, cb));
        const bf16x8 b1 = *reinterpret_cast<const bf16x8*>(Ks + kswz<DK>(32 + r32, cb));
        p0 = __builtin_amdgcn_mfma_f32_32x32x16_bf16(b0, qr[d0], p0, 0, 0, 0);
        p1 = __builtin_amdgcn_mfma_f32_32x32x16_bf16(b1, qr[d0], p1, 0, 0, 0); }
}
template <int DK> __device__ __forceinline__ void qkt_c(f32x16& p0, f32x16& p1, const char* Ks, const bf16x8* qr, const f32x16& negm, int r32, int hi) {
#pragma unroll
    for (int d0 = 0; d0 < DK / 16; ++d0) { const int cb = (d0 * 16 + hi * 8) * 2;
        const bf16x8 b0 = *reinterpret_cast<const bf16x8*>(Ks + kswz<DK>(r32, cb));
        const bf16x8 b1 = *reinterpret_cast<const bf16x8*>(Ks + kswz<DK>(32 + r32, cb));
        if (d0 == 0) { p0 = __builtin_amdgcn_mfma_f32_32x32x16_bf16(b0, qr[0], negm, 0, 0, 0); p1 = __builtin_amdgcn_mfma_f32_32x32x16_bf16(b1, qr[0], negm, 0, 0, 0); }
        else { p0 = __builtin_amdgcn_mfma_f32_32x32x16_bf16(b0, qr[d0], p0, 0, 0, 0); p1 = __builtin_amdgcn_mfma_f32_32x32x16_bf16(b1, qr[d0], p1, 0, 0, 0); } }
}
template <bool FIRST, bool SAFE = false> __device__ __forceinline__ void partialSM_pre(f32x16& p0, f32x16& p1, float& mref, f32x16& negm, float& alpha, const float thrl, const float l_now = 1.f) {
    float pmax = p0[0];
#pragma unroll
    for (int r = 1; r < 16; ++r) pmax = fmaxf(pmax, p0[r]);
#pragma unroll
    for (int r = 0; r < 16; ++r) pmax = fmaxf(pmax, p1[r]);
    { auto rr = __builtin_amdgcn_permlane32_swap(__float_as_uint(pmax), __float_as_uint(pmax), false, false); pmax = fmaxf(__uint_as_float(rr[0]), __uint_as_float(rr[1])); }
    alpha = 1.f;
    const bool fresh = SAFE && !FIRST && (l_now == 0.f), seen = !SAFE || (pmax > -INFINITY);
    if (FIRST || !__builtin_expect(__all((pmax <= thrl) && !(fresh && seen)), 1)) {
        const float dl = (FIRST || fresh) ? (seen ? pmax : 0.f) : fmaxf(pmax, 0.f);
        mref = FIRST ? dl : mref + dl;
#pragma unroll
        for (int r = 0; r < 16; ++r) { p0[r] -= dl; p1[r] -= dl; }
#pragma unroll
        for (int r = 0; r < 16; ++r) negm[r] = -mref;
        asm volatile("" : "+v"(negm));
        if (!FIRST && !fresh) alpha = __builtin_amdgcn_exp2f(-dl);
    }
#pragma unroll
    for (int r = 0; r < 16; ++r) p0[r] = __builtin_amdgcn_exp2f(p0[r]);
}
__device__ __forceinline__ void band_mask(f32x16& p0, f32x16& p1, int qp, int tk, int hi, int band, int wq0) {
    if (wq0 - (tk + 63) >= 0 && (wq0 + 31) - tk <= band) return;
    const int d0 = qp - tk - 4 * hi;
#pragma unroll
    for (int r = 0; r < 16; ++r) { const int d = d0 - ((r & 3) + 8 * (r >> 2));
        if ((unsigned)d > (unsigned)band) p0[r] = -INFINITY;
        if ((unsigned)(d - 32) > (unsigned)band) p1[r] = -INFINITY; }
}
__device__ __forceinline__ int v_st(int k, int c) { const int kk = (k & ~0xC) | ((k & 4) << 1) | ((k & 8) >> 1); return ((kk >> 3) * 4 + (c >> 5)) * 512 + ((kk & 7) * 32 + (c & 31)) * 2; }
__device__ __forceinline__ int v_rd_base(int lane) { return ((lane & 3) << 3) | (((lane >> 2) & 3) << 6) | (((lane >> 4) & 1) << 5) | (((lane >> 5) & 1) << 8); }
constexpr int v_rd_off(int d0, int ks, int half) { return d0 * 512 + ks * 4096 + half * 2048; }
template <int OFF> __device__ __forceinline__ s16x4 tr_read(int vb) { s16x4 r; asm volatile("ds_read_b64_tr_b16 %0, %1 offset:%2" : "=&v"(r) : "v"(vb), "i"(OFF) : "memory"); return r; }
struct VFrag { s16x4 l0, h0, l1, h1, l2, h2, l3, h3; };
template <int D0> __device__ __forceinline__ void pv_rd(VFrag& f, int vb) {
    f.l0 = tr_read<v_rd_off(D0, 0, 0)>(vb); f.h0 = tr_read<v_rd_off(D0, 0, 1)>(vb); f.l1 = tr_read<v_rd_off(D0, 1, 0)>(vb); f.h1 = tr_read<v_rd_off(D0, 1, 1)>(vb);
    f.l2 = tr_read<v_rd_off(D0, 2, 0)>(vb); f.h2 = tr_read<v_rd_off(D0, 2, 1)>(vb); f.l3 = tr_read<v_rd_off(D0, 3, 0)>(vb); f.h3 = tr_read<v_rd_off(D0, 3, 1)>(vb);
}
__device__ __forceinline__ void pv_mm(f32x16& od, const VFrag& f, bf16x8 pa0, bf16x8 pa1, bf16x8 pa2, bf16x8 pa3) {
#define FA_PK(L, H) (bf16x8){L[0], L[1], L[2], L[3], H[0], H[1], H[2], H[3]}
    od = __builtin_amdgcn_mfma_f32_32x32x16_bf16(pa0, FA_PK(f.l0, f.h0), od, 0, 0, 0);
    od = __builtin_amdgcn_mfma_f32_32x32x16_bf16(pa1, FA_PK(f.l1, f.h1), od, 0, 0, 0);
    od = __builtin_amdgcn_mfma_f32_32x32x16_bf16(pa2, FA_PK(f.l2, f.h2), od, 0, 0, 0);
    od = __builtin_amdgcn_mfma_f32_32x32x16_bf16(pa3, FA_PK(f.l3, f.h3), od, 0, 0, 0);
#undef FA_PK
}
template <bool PIPE> __device__ __forceinline__ void pv_d0(f32x16* o, int vb, bf16x8 pa0, bf16x8 pa1, bf16x8 pa2, bf16x8 pa3) {
    if constexpr (!PIPE) {
        VFrag f_;
        pv_rd<0>(f_, vb); asm volatile("s_waitcnt lgkmcnt(0)" ::: "memory"); FA_SBAR(); pv_mm(o[0], f_, pa0, pa1, pa2, pa3);
        pv_rd<1>(f_, vb); asm volatile("s_waitcnt lgkmcnt(0)" ::: "memory"); FA_SBAR(); pv_mm(o[1], f_, pa0, pa1, pa2, pa3);
        pv_rd<2>(f_, vb); asm volatile("s_waitcnt lgkmcnt(0)" ::: "memory"); FA_SBAR(); pv_mm(o[2], f_, pa0, pa1, pa2, pa3);
        pv_rd<3>(f_, vb); asm volatile("s_waitcnt lgkmcnt(0)" ::: "memory"); FA_SBAR(); pv_mm(o[3], f_, pa0, pa1, pa2, pa3);
        return;
    }
    VFrag fa_, fb_;
    FA_SBAR(); pv_rd<0>(fa_, vb); pv_rd<1>(fb_, vb);
    asm volatile("s_waitcnt lgkmcnt(8)" ::: "memory"); FA_SBAR(); pv_mm(o[0], fa_, pa0, pa1, pa2, pa3); FA_SBAR();
    pv_rd<2>(fa_, vb);
    asm volatile("s_waitcnt lgkmcnt(8)" ::: "memory"); FA_SBAR(); pv_mm(o[1], fb_, pa0, pa1, pa2, pa3); FA_SBAR();
    pv_rd<3>(fb_, vb);
    asm volatile("s_waitcnt lgkmcnt(8)" ::: "memory"); FA_SBAR(); pv_mm(o[2], fa_, pa0, pa1, pa2, pa3); FA_SBAR();
    asm volatile("s_waitcnt lgkmcnt(0)" ::: "memory"); FA_SBAR(); pv_mm(o[3], fb_, pa0, pa1, pa2, pa3); FA_SBAR();
}
template <bool SAFE, bool DOMASK = false> __device__ __forceinline__ void pv_psm(f32x16* o, int vb, bf16x8 pa0, bf16x8 pa1, bf16x8 pa2, bf16x8 pa3, f32x16& p0, f32x16& p1, float& mref, f32x16& negm, float& alpha, const float thrl, const float l_now,
                                                                                       const int md0 = 0, const int band = 0) {
    VFrag fa_, fb_; float pmax;
    FA_SBAR(); pv_rd<0>(fa_, vb); pv_rd<1>(fb_, vb);
    asm volatile("s_waitcnt lgkmcnt(8)" ::: "memory"); FA_SBAR();
    pv_mm(o[0], fa_, pa0, pa1, pa2, pa3);
    if constexpr (DOMASK) {
#pragma unroll
        for (int r = 0; r < 16; ++r) { const int d = md0 - ((r & 3) + 8 * (r >> 2)); if ((unsigned)d > (unsigned)band) p0[r] = -INFINITY; } }
    pmax = p0[0];
#pragma unroll
    for (int r = 1; r < 16; ++r) pmax = fmaxf(pmax, p0[r]);
    FA_SBAR();
    pv_rd<2>(fa_, vb);
    asm volatile("s_waitcnt lgkmcnt(8)" ::: "memory"); FA_SBAR();
    pv_mm(o[1], fb_, pa0, pa1, pa2, pa3);
    if constexpr (DOMASK) {
#pragma unroll
        for (int r = 0; r < 16; ++r) { const int d = md0 - 32 - ((r & 3) + 8 * (r >> 2)); if ((unsigned)d > (unsigned)band) p1[r] = -INFINITY; } }
#pragma unroll
    for (int r = 0; r < 16; ++r) pmax = fmaxf(pmax, p1[r]);
    { auto rr = __builtin_amdgcn_permlane32_swap(__float_as_uint(pmax), __float_as_uint(pmax), false, false); pmax = fmaxf(__uint_as_float(rr[0]), __uint_as_float(rr[1])); }
    FA_SBAR();
    pv_rd<3>(fb_, vb);
    alpha = 1.f;
    { const bool fresh = SAFE && (l_now == 0.f), seen = !SAFE || (pmax > -INFINITY);
      if (!__builtin_expect(__all((pmax <= thrl) && !(fresh && seen)), 1)) {
        const float dl = fresh ? (seen ? pmax : 0.f) : fmaxf(pmax, 0.f);
        mref = mref + dl;
#pragma unroll
        for (int r = 0; r < 16; ++r) { p0[r] -= dl; p1[r] -= dl; }
#pragma unroll
        for (int r = 0; r < 16; ++r) negm[r] = -mref;
        asm volatile("" : "+v"(negm));
        if (!fresh) alpha = __builtin_amdgcn_exp2f(-dl);
      } }
    asm volatile("s_waitcnt lgkmcnt(8)" ::: "memory"); FA_SBAR();
    pv_mm(o[2], fa_, pa0, pa1, pa2, pa3);
#pragma unroll
    for (int r = 0; r < 8; ++r) p0[r] = __builtin_amdgcn_exp2f(p0[r]);
    asm volatile("" : "+v"(p0));
    FA_SBAR();
    asm volatile("s_waitcnt lgkmcnt(0)" ::: "memory"); FA_SBAR();
    pv_mm(o[3], fb_, pa0, pa1, pa2, pa3);
#pragma unroll
    for (int r = 8; r < 16; ++r) p0[r] = __builtin_amdgcn_exp2f(p0[r]);
    asm volatile("" : "+v"(p0));
    FA_SBAR();
}
constexpr int NBUF = 3;
template <int DK> constexpr int lds_bytes() { return NBUF * SHM_V + NBUF * KVBLK * DK * 2 + 8 * 64 * 4; }
template <int DK> constexpr int ws_off() { return NBUF * SHM_V + NBUF * KVBLK * DK * 2; }
template <int DK, int DKA, bool MASKED, int SDEPTH>
__device__ __forceinline__ void body(const Desc& A, char* lds, const int tid, f32x16 (&o)[4], float& m_reg, float& l_reg, const float C, const float thrs) {
    constexpr int SHM_K = KVBLK * DK * 2, NK0 = DKA / 64, NK1 = (DK - DKA) / 64, NKC = NK0 + NK1, CPR0 = DKA / 8, CPR1 = (DK - DKA) / 8;
    const int wid = __builtin_amdgcn_readfirstlane(tid >> 6), lane = tid & 63, r32 = lane & 31, hi = lane >> 5;
    char* V_lds = lds; char* K_lds = lds + NBUF * SHM_V;
    float* ws = (float*)(lds + ws_off<DK>()) + wid * 64; float* al_l = ws + 32;
    m_reg = -1e30f; l_reg = 0.f;
#pragma unroll
    for (int d = 0; d < 4; ++d) o[d] = f32x16{};
    bf16x8 qr[DK / 16];
    { const int qoff = (wid * QBLK + r32) * (int)A.qstride + hi * 8;
#pragma unroll
      for (int d0 = 0; d0 < DK / 16; ++d0) qr[d0] = (d0 * 16 < DKA) ? *reinterpret_cast<const bf16x8*>(A.q0 + qoff + d0 * 16) : *reinterpret_cast<const bf16x8*>(A.q1 + qoff + (d0 * 16 - DKA)); }
    const int sr = tid >> 4, sc = (tid & 15) * 8, vst0 = v_st(sr, sc), vst1 = v_st(32 + sr, sc);
    const int vb0 = (int)(uintptr_t)V_lds + v_rd_base(lane);
    const int voff0 = sr * (int)A.vstride + sc, voff1 = (32 + sr) * (int)A.vstride + sc;
    int koff[NKC], kdst[NKC];
#pragma unroll
    for (int i = 0; i < NK0; ++i) { const int c = tid + 512 * i, row = c / CPR0, col = (c % CPR0) * 8; koff[i] = row * (int)A.k0stride + col; kdst[i] = kswz<DK>(row, col * 2); }
#pragma unroll
    for (int i = 0; i < NK1; ++i) { const int c = tid + 512 * i, row = c / (CPR1 ? CPR1 : 1), col = (c % (CPR1 ? CPR1 : 1)) * 8; koff[NK0 + i] = row * (int)A.k1stride + col; kdst[NK0 + i] = kswz<DK>(row, (DKA + col) * 2); }
    struct { bf16x8 vs0, vs1; bf16x8 ks[NKC]; } sr_[SDEPTH];
    const int qp = A.qpos0 + wid * QBLK + r32, wq0 = A.qpos0 + wid * QBLK;
#define FA_SLOAD(i, t) do { const long kp_ = (long)(t) * KVBLK; const bf16* vt_ = A.v + kp_ * A.vstride; const bf16* k0t_ = A.k0 + kp_ * A.k0stride; const bf16* k1t_ = A.k1 + kp_ * A.k1stride; \
    sr_[i].vs0 = *reinterpret_cast<const bf16x8*>(vt_ + voff0); sr_[i].vs1 = *reinterpret_cast<const bf16x8*>(vt_ + voff1); \
    _Pragma("unroll") for (int c_ = 0; c_ < NKC; ++c_) sr_[i].ks[c_] = *reinterpret_cast<const bf16x8*>((c_ < NK0 ? k0t_ : k1t_) + koff[c_]); } while (0)
#define FA_SWRITE(b, i) do { *(bf16x8*)(V_lds + (b) * SHM_V + vst0) = sr_[i].vs0; *(bf16x8*)(V_lds + (b) * SHM_V + vst1) = sr_[i].vs1; \
    _Pragma("unroll") for (int c_ = 0; c_ < NKC; ++c_) *(bf16x8*)(K_lds + (b) * SHM_K + kdst[c_]) = sr_[i].ks[c_]; } while (0)
#define FA_SWAIT() do { if constexpr (SDEPTH == 2) { if constexpr (NKC == 1) asm volatile("s_waitcnt vmcnt(3)" ::: "memory"); else if constexpr (NKC == 2) asm volatile("s_waitcnt vmcnt(4)" ::: "memory"); else asm volatile("s_waitcnt vmcnt(5)" ::: "memory"); } \
    else asm volatile("s_waitcnt vmcnt(0)" ::: "memory"); } while (0)
#define FA_RESC(a) do { if (__any((a) < 1.f)) { if (hi == 0) al_l[r32] = (a); asm volatile("s_waitcnt lgkmcnt(0)" ::: "memory"); \
    _Pragma("unroll") for (int d = 0; d < 4; ++d) _Pragma("unroll") for (int r = 0; r < 16; ++r) o[d][r] *= al_l[crow(r, hi)]; } } while (0)
#define FA_MASK(P0, P1, t) do { if constexpr (MASKED) band_mask(P0, P1, qp, (t) * KVBLK, hi, A.band, wq0); } while (0)
#define FA_ROT() do { const int t_ = bA; bA = bB; bB = bC; bC = t_; } while (0)
    f32x16 pA0, pA1, pB0, pB1; float mnA, mnB, alA, alB; bf16x8 pa0, pa1, pa2, pa3; const int NT = A.t1 - A.t0, T0 = A.t0;
    constexpr int SE = 0, SO = SDEPTH - 1;
    int bA = 2, bB = 0, bC = 1;
    FA_SLOAD(SE, T0); asm volatile("s_waitcnt vmcnt(0)" ::: "memory");
    __syncthreads();
    FA_SWRITE(0, SE); __syncthreads();
    qkt<DK>(pA0, pA1, K_lds, qr, r32, hi); FA_MASK(pA0, pA1, T0); partialSM(pA0, pA1, m_reg, mnA, alA, C, thrs);
    FA_SLOAD(SO, T0 + 1); if constexpr (SDEPTH == 2) { if (2 < NT) FA_SLOAD(SE, T0 + 2); }
    FA_SWAIT(); FA_SWRITE(1, SO); __syncthreads();
    FA_ROT();
    for (int j = 1; j + 1 < NT; j += 2) {
        FA_SBAR(); qkt<DK>(pB0, pB1, K_lds + bB * SHM_K, qr, r32, hi);
        finishSM(pA0, pA1, alA, l_reg, pa0, pa1, pa2, pa3); FA_SBAR();
        FA_SLOAD(SO, T0 + j + SDEPTH); FA_SBAR();
        pv_d0<PVPIPE_BODY(DK, MASKED)>(o, vb0 + bA * SHM_V, pa0, pa1, pa2, pa3); FA_MASK(pB0, pB1, T0 + j); partialSM(pB0, pB1, m_reg, mnB, alB, C, thrs);
        FA_SWAIT(); FA_SWRITE(bC, SE);
        FA_RESC(alB); __syncthreads(); FA_ROT();
        FA_SBAR(); qkt<DK>(pA0, pA1, K_lds + bB * SHM_K, qr, r32, hi);
        finishSM(pB0, pB1, alB, l_reg, pa0, pa1, pa2, pa3); FA_SBAR();
        if (SDEPTH == 1 || j + 3 < NT) FA_SLOAD(SE, T0 + j + 1 + SDEPTH); FA_SBAR();
        pv_d0<PVPIPE_BODY(DK, MASKED)>(o, vb0 + bA * SHM_V, pa0, pa1, pa2, pa3); FA_MASK(pA0, pA1, T0 + j + 1); partialSM(pA0, pA1, m_reg, mnA, alA, C, thrs);
        FA_SWAIT(); FA_SWRITE(bC, SO);
        FA_RESC(alA); __syncthreads(); FA_ROT();
    }
    FA_SBAR(); qkt<DK>(pB0, pB1, K_lds + bB * SHM_K, qr, r32, hi);
    finishSM(pA0, pA1, alA, l_reg, pa0, pa1, pa2, pa3); FA_SBAR();
    pv_d0<PVPIPE_BODY(DK, MASKED)>(o, vb0 + bA * SHM_V, pa0, pa1, pa2, pa3); FA_MASK(pB0, pB1, T0 + NT - 1); partialSM(pB0, pB1, m_reg, mnB, alB, C, thrs);
    FA_RESC(alB);
    finishSM(pB0, pB1, alB, l_reg, pa0, pa1, pa2, pa3); FA_SBAR();
    pv_d0<PVPIPE_BODY(DK, MASKED)>(o, vb0 + bB * SHM_V, pa0, pa1, pa2, pa3);
#undef FA_SLOAD
#undef FA_SWRITE
#undef FA_SWAIT
#undef FA_RESC
#undef FA_MASK
#undef FA_ROT
}
template <int DK, bool MASKED, bool PRESC = false, bool SAFE = false>
__device__ __forceinline__ void body_dma(const Desc& A, char* lds, const int tid, f32x16 (&o)[4], float& m_reg, float& l_reg, const float C, const float thrs) {
    constexpr int SHM_K = KVBLK * DK * 2, NKC = DK / 64, CPR = DK / 8;
    const int wid = __builtin_amdgcn_readfirstlane(tid >> 6), lane = tid & 63, r32 = lane & 31, hi = lane >> 5;
    char* V_lds = lds; char* K_lds = lds + NBUF * SHM_V;
    __attribute__((address_space(3))) char* l3 = (__attribute__((address_space(3))) char*)lds;
    float* ws = (float*)(lds + ws_off<DK>()) + wid * 64; float* al_l = ws + 32;
    m_reg = -1e30f; l_reg = 0.f;
#pragma unroll
    for (int d = 0; d < 4; ++d) o[d] = f32x16{};
    bf16x8 qr[DK / 16];
    { const int qoff = (wid * QBLK + r32) * (int)A.qstride + hi * 8;
#pragma unroll
      for (int d0 = 0; d0 < DK / 16; ++d0) qr[d0] = *reinterpret_cast<const bf16x8*>(A.q0 + qoff + d0 * 16); }
    int vsrc[2], ksrc[NKC];
#pragma unroll
    for (int i = 0; i < 2; ++i) { const int g = wid * 64 + i * 512 + lane, sub = g >> 5, w = g & 31, kk = (sub >> 2) * 8 + (w >> 2), k = (kk & ~0xC) | ((kk & 4) << 1) | ((kk & 8) >> 1), c = (sub & 3) * 32 + (w & 3) * 8;
        vsrc[i] = k * (int)A.vstride + c; }
#pragma unroll
    for (int i = 0; i < NKC; ++i) { const int g = wid * 64 + i * 512 + lane, row = g / CPR, ch = g % CPR, sch = ch ^ (row & 7); ksrc[i] = row * (int)A.k0stride + sch * 8; }
    const int vb0 = (int)(uintptr_t)V_lds + v_rd_base(lane);
    const int qp = A.qpos0 + wid * QBLK + r32, wq0 = A.qpos0 + wid * QBLK;
#define FA_DMA(slot, t) do { const long kp_ = (long)(t) * KVBLK; const bf16* vt_ = A.v + kp_ * A.vstride; const bf16* kt_ = A.k0 + kp_ * A.k0stride; \
    _Pragma("unroll") for (int i_ = 0; i_ < 2; ++i_) __builtin_amdgcn_global_load_lds((const unsigned*)(vt_ + (unsigned)vsrc[i_]), (__attribute__((address_space(3))) unsigned*)(l3 + (slot) * SHM_V + wid * 1024 + i_ * 8192), 16, 0, 0); \
    _Pragma("unroll") for (int i_ = 0; i_ < NKC; ++i_) __builtin_amdgcn_global_load_lds((const unsigned*)(kt_ + (unsigned)ksrc[i_]), (__attribute__((address_space(3))) unsigned*)(l3 + NBUF * SHM_V + (slot) * SHM_K + wid * 1024 + i_ * 8192), 16, 0, 0); } while (0)
#define FA_RESC(a) do { if (__any((a) < 1.f)) { if (hi == 0) al_l[r32] = (a); asm volatile("s_waitcnt lgkmcnt(0)" ::: "memory"); \
    _Pragma("unroll") for (int d = 0; d < 4; ++d) _Pragma("unroll") for (int r = 0; r < 16; ++r) o[d][r] *= al_l[crow(r, hi)]; } } while (0)
#define FA_MASK(P0, P1, t) do { if constexpr (MASKED) band_mask(P0, P1, qp, (t) * KVBLK, hi, A.band, wq0); } while (0)
#define FA_ROT() do { const int t_ = bA; bA = bB; bB = bC; bC = t_; } while (0)
#define FA_CLOSE() do { asm volatile("s_waitcnt vmcnt(0)" ::: "memory"); __syncthreads(); } while (0)
    f32x16 negm = f32x16{}; asm volatile("" : "+v"(negm));
#define FA_QKT(P0, P1, KS) do { if constexpr (PRESC) qkt_c<DK>(P0, P1, (KS), qr, negm, r32, hi); else qkt<DK>(P0, P1, (KS), qr, r32, hi); } while (0)
#define FA_PVPSM(P0, P1, AL, MN, t) do { if constexpr (PRESC && (PVX != 0)) { if constexpr (SAFE) pv_psm<true, true>(o, vb0 + bA * SHM_V, pa0, pa1, pa2, pa3, P0, P1, m_reg, negm, AL, thrs, l_reg, qp - (t) * KVBLK - 4 * hi, A.band);     \
      else { FA_MASK(P0, P1, t); pv_psm<false, false>(o, vb0 + bA * SHM_V, pa0, pa1, pa2, pa3, P0, P1, m_reg, negm, AL, thrs, l_reg); } } \
    else { pv_d0<true>(o, vb0 + bA * SHM_V, pa0, pa1, pa2, pa3); FA_MASK(P0, P1, t); FA_PSM(P0, P1, MN, AL, false); } } while (0)
#define FA_PSM(P0, P1, MN, AL, FIRST) do { if constexpr (PRESC) partialSM_pre<FIRST, SAFE>(P0, P1, m_reg, negm, AL, thrs, l_reg); else partialSM(P0, P1, m_reg, MN, AL, C, thrs); } while (0)
    f32x16 pA0, pA1, pB0, pB1; float mnA, mnB, alA, alB; bf16x8 pa0, pa1, pa2, pa3; const int NT = A.t1 - A.t0, T0 = A.t0;
    int bA = 0, bB = 1, bC = 2;
    __syncthreads();
    FA_DMA(0, T0); FA_DMA(1, T0 + 1);
    FA_CLOSE();
    FA_QKT(pA0, pA1, K_lds); FA_MASK(pA0, pA1, T0); FA_PSM(pA0, pA1, mnA, alA, true);
    for (int j = 1; j + 1 < NT; j += 2) {
        FA_SBAR(); FA_QKT(pB0, pB1, K_lds + bB * SHM_K);
        FA_DMA(bC, T0 + j + 1);
        finishSM(pA0, pA1, alA, l_reg, pa0, pa1, pa2, pa3); FA_SBAR();
        FA_PVPSM(pB0, pB1, alB, mnB, T0 + j);
        FA_RESC(alB); FA_CLOSE(); FA_ROT();
        FA_SBAR(); FA_QKT(pA0, pA1, K_lds + bB * SHM_K);
        if (j + 2 < NT) FA_DMA(bC, T0 + j + 2);
        finishSM(pB0, pB1, alB, l_reg, pa0, pa1, pa2, pa3); FA_SBAR();
        FA_PVPSM(pA0, pA1, alA, mnA, T0 + j + 1);
        FA_RESC(alA); FA_CLOSE(); FA_ROT();
    }
    FA_SBAR(); FA_QKT(pB0, pB1, K_lds + bB * SHM_K);
    finishSM(pA0, pA1, alA, l_reg, pa0, pa1, pa2, pa3); FA_SBAR();
    FA_PVPSM(pB0, pB1, alB, mnB, T0 + NT - 1);
    FA_RESC(alB);
    finishSM(pB0, pB1, alB, l_reg, pa0, pa1, pa2, pa3); FA_SBAR();
    pv_d0<true>(o, vb0 + bB * SHM_V, pa0, pa1, pa2, pa3);
#undef FA_DMA
#undef FA_RESC
#undef FA_MASK
#undef FA_ROT
#undef FA_CLOSE
#undef FA_QKT
#undef FA_PSM
#undef FA_PVPSM
}
template <int DK, int DKA, bool MASKED, bool PRESC = false>
__device__ __forceinline__ void body_sb(const Desc& A, char* lds, const int tid, f32x16 (&o)[4], float& m_reg, float& l_reg, const float C, const float thrs) {
    constexpr int SHM_K = KVBLK * DK * 2, NK0 = DKA / 64, NK1 = (DK - DKA) / 64, NKC = NK0 + NK1, CPR0 = DKA / 8, CPR1 = (DK - DKA) / 8;
    const int wid = __builtin_amdgcn_readfirstlane(tid >> 6), lane = tid & 63, r32 = lane & 31, hi = lane >> 5;
    char* V_lds = lds; char* K_lds = lds + 2 * SHM_V;
    float* ws = (float*)(lds + 2 * SHM_V + 2 * SHM_K) + wid * 64; float* al_l = ws + 32;
    m_reg = -1e30f; l_reg = 0.f;
#pragma unroll
    for (int d = 0; d < 4; ++d) o[d] = f32x16{};
    bf16x8 qr[DK / 16];
    { const int qoff = (wid * QBLK + r32) * A.qstride + hi * 8;
#pragma unroll
      for (int d0 = 0; d0 < DK / 16; ++d0) qr[d0] = (d0 * 16 < DKA) ? *reinterpret_cast<const bf16x8*>(A.q0 + qoff + d0 * 16) : *reinterpret_cast<const bf16x8*>(A.q1 + qoff + (d0 * 16 - DKA)); }
    const int sr = tid >> 4, sc = (tid & 15) * 8, vst0 = v_st(sr, sc), vst1 = v_st(32 + sr, sc);
    const int vb0 = (int)(uintptr_t)V_lds + v_rd_base(lane);
    const int voff0 = sr * A.vstride + sc, voff1 = (32 + sr) * A.vstride + sc;
    int koff[NKC], kdst[NKC];
#pragma unroll
    for (int i = 0; i < NK0; ++i) { const int c = tid + 512 * i, row = c / CPR0, col = (c % CPR0) * 8; koff[i] = row * A.k0stride + col; kdst[i] = kswz<DK>(row, col * 2); }
#pragma unroll
    for (int i = 0; i < NK1; ++i) { const int c = tid + 512 * i, row = c / (CPR1 ? CPR1 : 1), col = (c % (CPR1 ? CPR1 : 1)) * 8; koff[NK0 + i] = row * A.k1stride + col; kdst[NK0 + i] = kswz<DK>(row, (DKA + col) * 2); }
    bf16x8 vs0, vs1, ks[NKC];
    const int qp = A.qpos0 + wid * QBLK + r32, wq0 = A.qpos0 + wid * QBLK;
#define FA_SLOAD1(t) do { const long kp_ = (long)(t) * KVBLK; const bf16* vt_ = A.v + kp_ * A.vstride; const bf16* k0t_ = A.k0 + kp_ * A.k0stride; const bf16* k1t_ = A.k1 + kp_ * A.k1stride; \
    vs0 = *reinterpret_cast<const bf16x8*>(vt_ + voff0); vs1 = *reinterpret_cast<const bf16x8*>(vt_ + voff1); \
    _Pragma("unroll") for (int c_ = 0; c_ < NKC; ++c_) ks[c_] = *reinterpret_cast<const bf16x8*>((c_ < NK0 ? k0t_ : k1t_) + koff[c_]); } while (0)
#define FA_SWRITE1(b) do { *(bf16x8*)(V_lds + (b) * SHM_V + vst0) = vs0; *(bf16x8*)(V_lds + (b) * SHM_V + vst1) = vs1; \
    _Pragma("unroll") for (int c_ = 0; c_ < NKC; ++c_) *(bf16x8*)(K_lds + (b) * SHM_K + kdst[c_]) = ks[c_]; } while (0)
    f32x16 negm = f32x16{}; asm volatile("" : "+v"(negm));
    const int NT = A.t1 - A.t0, T0 = A.t0;
    FA_SLOAD1(T0); asm volatile("s_waitcnt vmcnt(0)" ::: "memory");
    __syncthreads();
    FA_SWRITE1(0); __syncthreads();
    for (int j = 0; j < NT; ++j) {
        const int bsel = j & 1;
        if (j + 1 < NT) FA_SLOAD1(T0 + j + 1);
        FA_SBAR();
        f32x16 p0, p1; float mn, al; bf16x8 pa0, pa1, pa2, pa3;
        if constexpr (PRESC) qkt_c<DK>(p0, p1, K_lds + bsel * SHM_K, qr, negm, r32, hi); else qkt<DK>(p0, p1, K_lds + bsel * SHM_K, qr, r32, hi);
        if constexpr (MASKED) band_mask(p0, p1, qp, (T0 + j) * KVBLK, hi, A.band, wq0);
        if constexpr (PRESC) { if (j == 0) partialSM_pre<true>(p0, p1, m_reg, negm, al, thrs); else partialSM_pre<false>(p0, p1, m_reg, negm, al, thrs); }
        else partialSM(p0, p1, m_reg, mn, al, C, thrs);
        finishSM(p0, p1, al, l_reg, pa0, pa1, pa2, pa3);
        if (__any(al < 1.f)) { if (hi == 0) al_l[r32] = al; asm volatile("s_waitcnt lgkmcnt(0)" ::: "memory");
#pragma unroll
            for (int d = 0; d < 4; ++d)
#pragma unroll
                for (int r = 0; r < 16; ++r) o[d][r] *= al_l[crow(r, hi)]; }
        FA_SBAR();
        pv_d0<PVPIPE_SB>(o, vb0 + bsel * SHM_V, pa0, pa1, pa2, pa3);
        if (j + 1 < NT) { asm volatile("s_waitcnt vmcnt(0)" ::: "memory"); FA_SWRITE1(bsel ^ 1); }
        __syncthreads();
    }
#undef FA_SLOAD1
#undef FA_SWRITE1
}
__device__ __forceinline__ void row_bcast(float x, float* ws, int r32, int hi, float (&out)[16]) {
    asm volatile("s_waitcnt lgkmcnt(0)" ::: "memory");
    if (hi == 0) ws[r32] = x; asm volatile("s_waitcnt lgkmcnt(0)" ::: "memory");
#pragma unroll
    for (int r = 0; r < 16; ++r) out[r] = ws[crow(r, hi)];
    asm volatile("s_waitcnt lgkmcnt(0)" ::: "memory");
}
}
constexpr float LOG2E = 1.4426950408889634f;
constexpr float FA_THR = 8.0f;
__device__ __forceinline__ void fa_store_bf16(const fa::f32x16 (&o)[4], const float (&f)[16], bf16* dst, long pitch, int r32, int hi) {
#pragma unroll
    for (int r = 0; r < 16; ++r) { bf16* rp = dst + (long)fa::crow(r, hi) * pitch + r32;
#pragma unroll
        for (int d0 = 0; d0 < 4; ++d0) rp[32 * d0] = (bf16)f2bf(o[d0][r] * f[r]); }
}
__device__ __forceinline__ void unit_mla(int b, int h, int qb, const bf16* QM, int qn0, int qns, int qr0, int qrs, const bf16* KVM, const bf16* U, bf16* Y, char* lds, int tid_in) {
    const int wid = __builtin_amdgcn_readfirstlane(tid_in >> 6), tid = wid * 64 + fresh_lane();
    fa::Desc A; const long row0 = (long)b * SEQ + qb * 256, kb = (long)b * SEQ;
    A.q0 = QM + row0 * NUQP + qn0 + h * qns; A.q1 = QM + row0 * NUQP + qr0 + h * qrs; A.qstride = NUQP;
    A.k0 = KVM + kb * NUKV + h * 256; A.k0stride = NUKV; A.k1 = U + kb * NINP + UC_KR; A.k1stride = NINP;
    A.v = KVM + kb * NUKV + h * 256 + 128; A.vstride = NUKV;
    A.t0 = 0; A.t1 = 4 * (qb + 1); A.qpos0 = qb * 256; A.band = 1 << 30;
    constexpr float SC = 0.07216878364870322f;
    fa::f32x16 o[4]; float m, l; fa::body_sb<192, 128, true, (PRESC_MLA != 0)>(A, lds, tid, o, m, l, PRESC_MLA ? 1.0f : SC * LOG2E, PRESC_MLA ? FA_THR * LOG2E : FA_THR / SC);
    { const int le = fresh_lane(), r32 = le & 31, hi = le >> 5;
    float* ws = (float*)(lds + 2 * fa::SHM_V + 2 * 64 * 192 * 2) + wid * 64; float rl[16]; fa::row_bcast(1.0f / l, ws, r32, hi, rl);
    fa_store_bf16(o, rl, Y + (row0 + wid * 32) * DM + 512 + h * 128, DM, r32, hi); }
}
__device__ __forceinline__ void unit_diff(int b, int h, int qb, const bf16* U, float* A1, bf16* Y, const float* subln, float lam, float lam_init, char* lds, int tid_in) {
    const int wid = __builtin_amdgcn_readfirstlane(tid_in >> 6), tid = wid * 64 + fresh_lane();
    const long row0 = (long)b * SEQ + qb * 256, kb = (long)b * SEQ;
    float* ws = (float*)(lds + fa::ws_off<64>()) + wid * 64;
    constexpr float SC = 0.125f;
    for (int pass = 0; pass < 2; ++pass) {
        fa::Desc A;
        A.q0 = U + row0 * NINP + (pass ? UC_Q2 : UC_Q1) + h * 64; A.q1 = A.q0; A.qstride = NINP;
        A.k0 = U + kb * NINP + (pass ? UC_K2 : UC_K1) + h * 64; A.k0stride = NINP; A.k1 = A.k0; A.k1stride = NINP;
        A.v = U + kb * NINP + UC_VA + h * 128; A.vstride = NINP;
        A.t0 = 0; A.t1 = 4 * (qb + 1); A.qpos0 = qb * 256; A.band = 1 << 30;
        fa::f32x16 o[4]; float m, l; if constexpr (DMA_DIFF != 0) fa::body_dma<64, true, (PRESC_DIFF != 0)>(A, lds, tid, o, m, l, PRESC_DIFF ? 1.0f : SC * LOG2E, PRESC_DIFF ? FA_THR * LOG2E : FA_THR / SC); else fa::body<64, 64, true, 2>(A, lds, tid, o, m, l, SC * LOG2E, FA_THR / SC);
        const int lane = fresh_lane(), r32 = lane & 31, hi = lane >> 5;
        float rl[16]; fa::row_bcast(1.0f / l, ws, r32, hi, rl);
        float* a1p = A1 + (row0 + wid * 32) * 512 + h * 128 + r32;
        if (pass == 0) {
#pragma unroll
            for (int r = 0; r < 16; ++r)
#pragma unroll
                for (int d0 = 0; d0 < 4; ++d0) a1p[(long)fa::crow(r, hi) * 512 + 32 * d0] = o[d0][r] * rl[r];
        } else {
            float sg[4];
#pragma unroll
            for (int d0 = 0; d0 < 4; ++d0) sg[d0] = subln[32 * d0 + r32] * (1.0f - lam_init);
#pragma unroll
            for (int r = 0; r < 16; ++r) { float ss = 0.f;
#pragma unroll
                for (int d0 = 0; d0 < 4; ++d0) { const float x = a1p[(long)fa::crow(r, hi) * 512 + 32 * d0] - lam * (o[d0][r] * rl[r]); o[d0][r] = x; ss += x * x; }
#pragma unroll
                for (int s = 1; s < 32; s <<= 1) ss += lane_xor(ss, lane, s);
                rl[r] = 1.0f / sqrtf(ss * (1.0f / 128.0f) + 1e-5f); }
#pragma unroll
            for (int r = 0; r < 16; ++r)
#pragma unroll
                for (int d0 = 0; d0 < 4; ++d0) o[d0][r] *= sg[d0];
            fa_store_bf16(o, rl, Y + (row0 + wid * 32) * DM + h * 128, DM, r32, hi);
        }
    }
}
__device__ __forceinline__ void unit_dil(int g, int b, int h, int ub, const bf16* U, bf16* OD, float* LSE, char* lds, int tid_in) {
    const int wid = __builtin_amdgcn_readfirstlane(tid_in >> 6), tid = wid * 64 + fresh_lane();
    const int dil = (g == 0) ? 1 : (g == 1) ? 4 : 16, res = ub % dil, m0 = 256 * (ub / dil);
    const long base = (long)b * SEQ + res;
    fa::Desc A;
    A.q0 = U + (base + (long)m0 * dil) * NINP + UC_QC + h * 128; A.q1 = A.q0; A.qstride = dil * NINP;
    A.k0 = U + base * NINP + UC_KC + h * 128; A.k0stride = dil * NINP; A.k1 = A.k0; A.k1stride = A.k0stride;
    A.v = U + base * NINP + UC_VC + h * 128; A.vstride = dil * NINP;
    A.t0 = (m0 >= 128) ? (m0 - 128) / 64 : 0; A.t1 = (m0 + 256) / 64; A.qpos0 = m0; A.band = 128;
    constexpr float SC = 0.08838834764831845f;
    fa::f32x16 o[4]; float m, l; if constexpr (DMA_DIL != 0) fa::body_dma<128, true, (PRESC_DIL != 0), true>(A, lds, tid, o, m, l, PRESC_DIL ? 1.0f : SC * LOG2E, PRESC_DIL ? FA_THR * LOG2E : FA_THR / SC); else fa::body<128, 128, true, 2>(A, lds, tid, o, m, l, SC * LOG2E, FA_THR / SC);
    const int le = fresh_lane(), r32 = le & 31, hi = le >> 5;
    float* ws = (float*)(lds + fa::ws_off<128>()) + wid * 64; float rl[16]; fa::row_bcast(1.0f / l, ws, r32, hi, rl);
    bf16* od = OD + (size_t)g * M * 768;
    const long tok0 = base + (long)(m0 + wid * 32) * dil;
#pragma unroll
    for (int r = 0; r < 16; ++r) { bf16* rp = od + (tok0 + (long)fa::crow(r, hi) * dil) * 768 + h * 128 + r32;
#pragma unroll
        for (int d0 = 0; d0 < 4; ++d0) rp[32 * d0] = (bf16)f2bf(o[d0][r] * rl[r]); }
    if (hi == 0) LSE[(size_t)g * M * 8 + (tok0 + (long)r32 * dil) * 8 + h] = m * (PRESC_DIL ? (1.0f / LOG2E) : SC) + __logf(l);
}
__device__ __forceinline__ void dil_merge(const bf16* OD, const float* LSE, bf16* Y, int it0, int itend, int gsize) {
    for (int it = it0; it < itend; it += gsize) { const int m = it / 96, c8 = (it % 96) * 8, h = c8 >> 7;
        const float l0 = LSE[(size_t)m * 8 + h], l1 = LSE[(size_t)M * 8 + (size_t)m * 8 + h], l2 = LSE[(size_t)2 * M * 8 + (size_t)m * 8 + h];
        const float mx = fmaxf(l0, fmaxf(l1, l2)); float w0 = __expf(l0 - mx), w1 = __expf(l1 - mx), w2 = __expf(l2 - mx); const float inv = 1.0f / (w0 + w1 + w2); w0 *= inv; w1 *= inv; w2 *= inv;
        const v4u p0 = *(const v4u*)(OD + (size_t)m * 768 + c8), p1 = *(const v4u*)(OD + (size_t)M * 768 + (size_t)m * 768 + c8), p2 = *(const v4u*)(OD + (size_t)2 * M * 768 + (size_t)m * 768 + c8);
        v4u o;
#pragma unroll
        for (int i = 0; i < 4; ++i) o[i] = pk2(bflo(p0[i]) * w0 + bflo(p1[i]) * w1 + bflo(p2[i]) * w2, bfhi(p0[i]) * w0 + bfhi(p1[i]) * w1 + bfhi(p2[i]) * w2);
        *(v4u*)(Y + (size_t)m * DM + 1280 + c8) = o; }
}
__device__ __forceinline__ void unit_cross(int rb, int h, const bf16* CQ2, const bf16* KVC, bf16* OC, char* lds, int tid_in) {
    const int wid = __builtin_amdgcn_readfirstlane(tid_in >> 6), tid = wid * 64 + fresh_lane();
    const long row0 = (long)rb * 256; const int b = rb / (SEQ / 256);
    fa::Desc A;
    A.q0 = CQ2 + row0 * 512 + h * 128; A.q1 = A.q0; A.qstride = 512;
    A.k0 = KVC + (long)b * MEML * 1024 + h * 128; A.k0stride = 1024; A.k1 = A.k0; A.k1stride = 1024;
    A.v = A.k0 + 512; A.vstride = 1024;
    A.t0 = 0; A.t1 = MEML / 64; A.qpos0 = 0; A.band = 1 << 30;
    constexpr float SC = 0.08838834764831845f;
    fa::f32x16 o[4]; float m, l; if constexpr (DMA_CROSS != 0) fa::body_dma<128, false, (PRESC_CROSS != 0)>(A, lds, tid, o, m, l, PRESC_CROSS ? 1.0f : SC * LOG2E, PRESC_CROSS ? FA_THR * LOG2E : FA_THR / SC); else fa::body<128, 128, false, 2>(A, lds, tid, o, m, l, SC * LOG2E, FA_THR / SC);
    const int le = fresh_lane(), r32 = le & 31, hi = le >> 5;
    float* ws = (float*)(lds + fa::ws_off<128>()) + wid * 64; float rl[16]; fa::row_bcast(1.0f / l, ws, r32, hi, rl);
    fa_store_bf16(o, rl, OC + (row0 + wid * 32) * 512 + h * 128, 512, r32, hi);
}
constexpr int NU_CAUSAL = 16 * 40, NU_DIL = 3 * 24 * 16, NU_MIX = NU_CAUSAL + NU_DIL;

__device__ __noinline__ void grid_bar(GAS unsigned* barw, unsigned x, volatile LAS unsigned* st, int leader) { XcdBarrier b; b.bar = (unsigned*)barw; b.x = x; b.st = st; xcd_barrier(b, leader != 0); }
__device__ __noinline__ void local_bar(GAS unsigned* lbw, unsigned x, unsigned nloc, int leader) {
    asm volatile("s_waitcnt vmcnt(0)" ::: "memory");
    __syncthreads();
    if (leader) {
        unsigned* b = (unsigned*)lbw;
        __builtin_amdgcn_s_waitcnt(0);
        const unsigned old = xb_add(&b[XB_XCNT(x)], 1u), tgt = (old / nloc + 1u) * nloc;
        if (old + 1u != tgt) XB_SPIN(xb_ld(&b[XB_XCNT(x)]) < tgt, b);
        __builtin_amdgcn_fence(__ATOMIC_ACQUIRE, "agent");
        asm volatile("s_waitcnt vmcnt(0)" ::: "memory");
    }
    __syncthreads();
}
__device__ __forceinline__ void wg_publish(gu32* ctr, int leader) {
    asm volatile("s_waitcnt vmcnt(0)" ::: "memory"); __syncthreads();
    if (leader) { __builtin_amdgcn_fence(__ATOMIC_RELEASE, "agent"); asm volatile("s_waitcnt vmcnt(0)" ::: "memory"); (void)__hip_atomic_fetch_add(ctr, 1u, RLX_AGENT); }
}
__device__ __forceinline__ void wg_wait(gu32* ctr, unsigned target, int leader) {
    if (leader) { unsigned sp = 0; while (__hip_atomic_load(ctr, RLX_AGENT) < target) { __builtin_amdgcn_s_sleep(1); if (++sp > (1u << 22)) break; }
        __builtin_amdgcn_fence(__ATOMIC_ACQUIRE, "agent"); asm volatile("s_waitcnt vmcnt(0)" ::: "memory"); }
    __syncthreads();
}
__device__ __forceinline__ void final_norm_hilo(const bf16* HB, const bf16* LO, float* out, const float* g, int m0, int mend, int NGW, int lane) {
    for (int m = m0; m < mend; m += NGW) {
        float v[4][8]; float s = 0.f;
#pragma unroll
        for (int j = 0; j < 4; ++j) { const v4u h = *(const v4u*)(HB + (size_t)m * DM + 512 * j + 8 * lane); v4u l = {0u, 0u, 0u, 0u}; if (LO) l = *(const v4u*)(LO + (size_t)m * DM + 512 * j + 8 * lane);
#pragma unroll
            for (int i = 0; i < 4; ++i) { v[j][2 * i] = bflo(h[i]) + bflo(l[i]); v[j][2 * i + 1] = bfhi(h[i]) + bfhi(l[i]); s += v[j][2 * i] * v[j][2 * i] + v[j][2 * i + 1] * v[j][2 * i + 1]; } }
        const float rstd = 1.0f / sqrtf(wave_sum(s, lane) * (1.0f / DM) + 1e-6f);
#pragma unroll
        for (int j = 0; j < 4; ++j) { const f32x4 g0 = *(const f32x4*)(g + 512 * j + 8 * lane), g1 = *(const f32x4*)(g + 512 * j + 8 * lane + 4);
            f32x4 o0, o1; o0.x = v[j][0] * rstd * g0.x; o0.y = v[j][1] * rstd * g0.y; o0.z = v[j][2] * rstd * g0.z; o0.w = v[j][3] * rstd * g0.w;
            o1.x = v[j][4] * rstd * g1.x; o1.y = v[j][5] * rstd * g1.y; o1.z = v[j][6] * rstd * g1.z; o1.w = v[j][7] * rstd * g1.w;
            *(f32x4*)(out + (size_t)m * DM + 512 * j + 8 * lane) = o0; *(f32x4*)(out + (size_t)m * DM + 512 * j + 8 * lane + 4) = o1; }
    }
}
#ifndef LOCAL_SEAMS
#define LOCAL_SEAMS 1
#endif
#ifndef ST_SWIGLU
#define ST_SWIGLU 1
#endif
#ifndef ST_NORM
#define ST_NORM 1
#endif
#ifndef ST_HILO
#define ST_HILO 1
#endif
#ifndef ST_MIX
#define ST_MIX 1
#endif
#ifndef PROBE_DUP
#define PROBE_DUP (-100)
#endif
#define REPS(slot) (((slot) == PROBE_DUP) ? 2 : 1)
constexpr int NPL = 20;
constexpr int PH_TOTAL = 1 + DEPTH * NPL + 1;
enum { RM_ID = 0, RM_GU = 1, RM_WINPAD = 2, RM_WIN = 3, RM_UQ = 4 };
template <int MODE> __device__ __forceinline__ int row_map(int n, int off) {
    if (MODE == RM_GU) return (n >> 7) * 256 + off + (n & 127);
    if (MODE == RM_WINPAD) return n < 2624 ? n : n + 192;
    if (MODE == RM_WIN) { const int cp = n < 2624 ? n : n + 192, t = cp >> 8, c = cp & 255, k = pg8::win_kind(t); return t * 256 + (k == 2 ? pg8::rope_perm64(c) : k == 3 ? pg8::rope_perm128(c) : c); }
    if (MODE == RM_UQ) { const int h = n / 192, w = n % 192; if (w < 128) return h * 128 + w; const int r = w - 128; return (3 + (h >> 2)) * 256 + (r >> 5) * 128 + (h & 3) * 32 + (r & 31); }
    return n + off;
}
__device__ __forceinline__ void conv_load(float (&v)[32], const float* W, int N, int nblk, int item, int lane) {
    const int kb = item / nblk, nb = item % nblk; const float* p = W + (size_t)(64 * kb + (lane >> 5)) * N + 32 * nb + (lane & 31);
#pragma unroll
    for (int i = 0; i < 32; ++i) v[i] = p[(size_t)(2 * i) * N];
}
template <int MODE> __device__ __forceinline__ void conv_store(const float (&v)[32], int K, int nblk, bf16* WT, int off, const float* gain, LAS float* scr, int item, int lane) {
    const int kb = item / nblk, nb = item % nblk, k0 = 64 * kb, n0 = 32 * nb, c = lane & 7;
#pragma unroll
    for (int i = 0; i < 32; ++i) scr[(2 * i + (lane >> 5)) * 33 + (lane & 31)] = v[i];
    float g8[8];
#pragma unroll
    for (int i = 0; i < 8; ++i) g8[i] = gain ? gain[k0 + 8 * c + i] : 1.0f;
    LDS_WAIT(); asm volatile("" ::: "memory");
#pragma unroll
    for (int j = 0; j < 4; ++j) { const int n = (lane >> 3) + 8 * j; const LAS float* s = scr + (8 * c) * 33 + n;
        v4u o; o.x = pk2(s[0 * 33] * g8[0], s[1 * 33] * g8[1]); o.y = pk2(s[2 * 33] * g8[2], s[3 * 33] * g8[3]); o.z = pk2(s[4 * 33] * g8[4], s[5 * 33] * g8[5]); o.w = pk2(s[6 * 33] * g8[6], s[7 * 33] * g8[7]);
        *(GAS v4u*)(WT + (size_t)row_map<MODE>(n0 + n, off) * K + k0 + 8 * c) = o; }
    LDS_WAIT(); asm volatile("" ::: "memory");
}
template <int MODE> __device__ __forceinline__ void conv_matrix(const float* W, int K, int N, bf16* WT, int off, const float* gain, LAS float* scr, int gw, int NGW, int lane) {
    const int nblk = N / 32, nit = (K / 64) * nblk; float va[32], vb[32];
    int it = gw; if (it < nit) conv_load(va, W, N, nblk, it, lane);
    while (it < nit) {
        int nx = it + NGW; if (nx < nit) conv_load(vb, W, N, nblk, nx, lane);
        conv_store<MODE>(va, K, nblk, WT, off, gain, scr, it, lane); it = nx; if (it >= nit) break;
        nx = it + NGW; if (nx < nit) conv_load(va, W, N, nblk, nx, lane);
        conv_store<MODE>(vb, K, nblk, WT, off, gain, scr, it, lane); it = nx;
    }
}
#define CONV2(MODE, Wp, K_, N_, WTp, off, gain) conv_matrix<MODE>((Wp), (K_), (N_), (WTp), (off), (gain), scr, gw, NGW, lane)
template <int NPART> __device__ __forceinline__ void rows_to_bf16_stats(const float* src, bf16* dst, bf16* lo, float* S, int nrows, int gw, int NGW, int lane) {
    for (int m = gw; m < nrows; m += NGW) {
        const f32x4* xr = (const f32x4*)(src + (size_t)m * DM) + lane; f32x4 v[8]; float s = 0.f;
#pragma unroll
        for (int j = 0; j < 8; ++j) { v[j] = xr[64 * j]; s += (v[j].x * v[j].x + v[j].y * v[j].y) + (v[j].z * v[j].z + v[j].w * v[j].w); }
        s = wave_sum(s, lane);
        unsigned long long* o8 = (unsigned long long*)(dst + (size_t)m * DM) + lane;
#pragma unroll
        for (int j = 0; j < 8; ++j) o8[64 * j] = (unsigned long long)pk2(v[j].x, v[j].y) | ((unsigned long long)pk2(v[j].z, v[j].w) << 32);
        if (lo) { unsigned long long* l8 = (unsigned long long*)(lo + (size_t)m * DM) + lane;
#pragma unroll
            for (int j = 0; j < 8; ++j) { const unsigned p0 = pk2(v[j].x, v[j].y), p1 = pk2(v[j].z, v[j].w);
                l8[64 * j] = (unsigned long long)pk2(v[j].x - bflo(p0), v[j].y - bfhi(p0)) | ((unsigned long long)pk2(v[j].z - bflo(p1), v[j].w - bfhi(p1)) << 32); } }
        if (lane < NPART) S[(size_t)m * NPART + lane] = (lane == 0) ? s : 0.f;
    }
}
__global__ void __launch_bounds__(NWAVES * 64, 2) mk_fwd(Params P) {
    extern __shared__ __attribute__((aligned(16))) unsigned char lds_raw[];
    LAS unsigned char* lds = (LAS unsigned char*)lds_raw;
    volatile LAS unsigned* MISC = (volatile LAS unsigned*)(lds + MISC_OFF);
    const int wave_s = __builtin_amdgcn_readfirstlane(threadIdx.x >> 6);
#define IDS int bx = blockIdx.x, G = gridDim.x, wave = wave_s; asm volatile("" : "+s"(bx), "+s"(G), "+s"(wave)); \
    const int lane = fresh_lane(), tid = wave * 64 + lane, gw = bx * NWAVES + wave, NGW = G * NWAVES, gtid = bx * (NWAVES * 64) + tid, gsize = G * NWAVES * 64; \
    const int lok = __builtin_amdgcn_readfirstlane((int)MISC[18]), xcc = __builtin_amdgcn_readfirstlane((int)MISC[16]), xrank = __builtin_amdgcn_readfirstlane((int)MISC[17]); \
    const int cv = lok ? (xrank * 8 + xcc) : bx;     \
    const int pair = lok ? (xcc >> 1) : 0, pidx = lok ? ((xcc & 1) * (G >> 3) + xrank) : bx, PG = lok ? (G >> 2) : G, NQG = lok ? 4 : 1;     \
    (void)lane; (void)gw; (void)NGW; (void)gtid; (void)gsize; (void)cv; (void)xcc; (void)xrank; (void)pair; (void)pidx; (void)PG; (void)NQG;
    typedef const volatile __attribute__((address_space(4))) Params* KArg;
    KArg vp = (KArg)__builtin_amdgcn_kernarg_segment_ptr();
#define PIN(i) ((const float*)vp->in[i])
#define WS (vp->ws)
#define CTLP ((gu32*)(WS + WS_CTL))
    for (int u = threadIdx.x; u < (LDS_BYTES - LDSCTL_OFF) / 4; u += NWAVES * 64) ((LAS unsigned*)(lds + LDSCTL_OFF))[u] = 0u;
    __syncthreads();
    if (P.use_bar && threadIdx.x == 0) { const unsigned x_ = xb_xcc_id(); MISC[17] = xb_add((unsigned*)(CTLP + CW_BAR) + XB_XCNT(x_), 1u); MISC[16] = x_; }
#define IN(k) (vp->ph_lo <= (k) && (k) < vp->ph_hi)
#define SEAM(k) do { if (IN(k) && IN((k) + 1)) { const int ldr_ = (wave_s == 0 && fresh_lane() == 0) ? 1 : 0; grid_bar((GAS unsigned*)(CTLP + CW_BAR), xb_xcc_id(), (volatile LAS unsigned*)(lds + MISC_OFF) + 8, ldr_); } } while (0)
#define SEAM_L(k) do { if (IN(k) && IN((k) + 1)) { const int ldr_ = (wave_s == 0 && fresh_lane() == 0) ? 1 : 0; \
    if (MISC[18]) local_bar((GAS unsigned*)(CTLP + CW_LBAR), (unsigned)__builtin_amdgcn_readfirstlane((int)MISC[16]), gridDim.x / 8u, ldr_); \
    else grid_bar((GAS unsigned*)(CTLP + CW_BAR), xb_xcc_id(), (volatile LAS unsigned*)(lds + MISC_OFF) + 8, ldr_); } } while (0)
#define SEAM_P(k) do { if (IN(k) && IN((k) + 1)) { const int ldr_ = (wave_s == 0 && fresh_lane() == 0) ? 1 : 0; \
    if (MISC[18]) { const unsigned x_ = (unsigned)__builtin_amdgcn_readfirstlane((int)MISC[16]); grid_bar((GAS unsigned*)(CTLP + CW_PBAR) + (x_ >> 1) * XCD_BAR_WORDS, x_, (volatile LAS unsigned*)(lds + MISC_OFF) + 20, ldr_); } \
    else grid_bar((GAS unsigned*)(CTLP + CW_BAR), xb_xcc_id(), (volatile LAS unsigned*)(lds + MISC_OFF) + 8, ldr_); } } while (0)
#define HH (vp->out)
#define WSB(off) ((bf16*)(WS + (off)))
#define WSF(off) ((float*)(WS + (off)))
#define WL(l) (WSB(WS_W) + (size_t)(l) * W_LAYER)
#define RCACHE_DEF(NP, Sp, invn) int pm0_ = 0; { pg8::Unit u0_{0, 0}; if (S.next(0, u0_)) pm0_ = u0_.pm; } const pg8::RstdCache rc_ = pg8::rstd_cache_fill<NP>((LAS float*)(lds + RSTD_OFF), (Sp), pm0_, tid, (invn), 1e-6f);
#define GEMM_PH(EPI, ...) pg8::gemm_phase<EPI, pg8::StaticOrder, true, true>(lds + RING_OFF, g, S, E, tid)

    if (IN(0)) for (int rep = 0; rep < REPS(-1); ++rep) { IDS
        LAS float* scr = (LAS float*)(lds + RING_OFF + wave * 16384);
        for (int l = 0; l < DEPTH; ++l) {
            const float* gF1 = ST_NORM ? PIN(I_F1N) + l * DM : nullptr; const float* gF2 = ST_NORM ? PIN(I_F2N) + l * DM : nullptr; const float* gMX = ST_NORM ? PIN(I_MIXN) + l * DM : nullptr;
            const float* gCR = ST_NORM ? PIN(I_CRN) + l * DM : nullptr; const float* gME = ST_NORM ? PIN(I_MEMN) + l * DM : nullptr;
            const float* gQ = ST_MIX ? PIN(I_QN) + l * 512 : nullptr; const float* gKV = ST_MIX ? PIN(I_KVN) + l * 512 : nullptr;
            constexpr int MGU = ST_SWIGLU ? RM_GU : RM_ID, OFU = ST_SWIGLU ? 128 : FF;
            CONV2(MGU, PIN(I_F1G) + (size_t)l * DM * FF, DM, FF, WL(l) + WO_GU1, 0, gF1);
            CONV2(MGU, PIN(I_F1U) + (size_t)l * DM * FF, DM, FF, WL(l) + WO_GU1, OFU, gF1);
            CONV2(RM_ID, PIN(I_F1D) + (size_t)l * FF * DM, FF, DM, WL(l) + WO_D1, 0, nullptr);
            CONV2((ST_MIX ? RM_WIN : RM_WINPAD), PIN(I_WIN) + (size_t)l * DM * NIN, DM, NIN, WL(l) + WO_IN, 0, gMX);
            CONV2((ST_MIX ? RM_UQ : RM_ID), PIN(I_WUQ) + (size_t)l * 512 * NUQ, 512, NUQ, WL(l) + WO_UQ, 0, gQ);
            CONV2(RM_ID, PIN(I_WUKV) + (size_t)l * 512 * NUKV, 512, NUKV, WL(l) + WO_UKV, 0, gKV);
            CONV2(RM_ID, PIN(I_WOUT) + (size_t)l * DM * DM, DM, DM, WL(l) + WO_OUT, 0, nullptr);
            CONV2(RM_ID, PIN(I_CWQ) + (size_t)l * DM * 512, DM, 512, WL(l) + WO_CQ, 0, gCR);
            CONV2(RM_ID, PIN(I_CWKV) + (size_t)l * DM * 1024, DM, 1024, WL(l) + WO_CKV, 0, gME);
            CONV2(RM_ID, PIN(I_CWO) + (size_t)l * 512 * DM, 512, DM, WL(l) + WO_CO, 0, nullptr);
            CONV2(MGU, PIN(I_F2G) + (size_t)l * DM * FF, DM, FF, WL(l) + WO_GU2, 0, gF2);
            CONV2(MGU, PIN(I_F2U) + (size_t)l * DM * FF, DM, FF, WL(l) + WO_GU2, OFU, gF2);
            CONV2(RM_ID, PIN(I_F2D) + (size_t)l * FF * DM, FF, DM, WL(l) + WO_D2, 0, nullptr);
            for (int it = gtid; it < 192 * DM / 8; it += gsize) { const int rr = it / (DM / 8), c8 = it % (DM / 8), cp = 2624 + rr; const int row = ST_MIX ? (2560 + pg8::rope_perm64(cp - 2560)) : cp;
                *(v4u*)(WL(l) + WO_IN + (size_t)row * DM + (size_t)c8 * 8) = (v4u){0u, 0u, 0u, 0u}; }
            for (int it = gtid; it < 128 * 512 / 8; it += gsize) { const int rr = it / 64, c8 = it % 64; const int row = ST_MIX ? (4 * 256 + (rr >> 6) * 128 + (2 + ((rr >> 5) & 1)) * 32 + (rr & 31)) : (NUQ + rr);
                *(v4u*)(WL(l) + WO_UQ + (size_t)row * 512 + (size_t)c8 * 8) = (v4u){0u, 0u, 0u, 0u}; }
        }
        const int* pos = (const int*)PIN(I_POS);
        for (int it = gtid; it < M * 32; it += gsize) { const int m = it >> 5, i = it & 31; float c, s; sincos_rad((float)pos[m] * vp->inv64[i], c, s); WSF(WS_COS64)[it] = c; WSF(WS_SIN64)[it] = s; }
        for (int it = gtid; it < M * 64; it += gsize) { const int m = it >> 6, i = it & 63; float c, s; sincos_rad((float)pos[m] * vp->inv128[i], c, s); WSF(WS_COS128)[it] = c; WSF(WS_SIN128)[it] = s; }
        if (gtid < DEPTH) { const float* lp = PIN(I_DLAM) + gtid * 256; float a = 0.f, b2 = 0.f;
            for (int i = 0; i < 64; ++i) { a += lp[i] * lp[64 + i]; b2 += lp[128 + i] * lp[192 + i]; }
            WSF(WS_LAM)[gtid] = expf(a) - expf(b2) + vp->lam_init[gtid]; }
#if ST_NORM
        rows_to_bf16_stats<32>(PIN(I_X), WSB(WS_XN), (ST_HILO == 1) ? WSB(WS_LO) : nullptr, WSF(WS_STATS), M, gw, NGW, lane);
        rows_to_bf16_stats<8>(PIN(I_MEM), WSB(WS_MEMB), nullptr, WSF(WS_MSTAT), MMEM, gw, NGW, lane);
#endif
    }
    SEAM(0);
    if (IN(0) && IN(1)) {
        if (wave_s == 0 && fresh_lane() == 0) { const unsigned G_ = gridDim.x; unsigned ok = (G_ % 8u == 0u) ? 1u : 0u;
            for (unsigned j = 0; j < 16; ++j) { const unsigned c_ = xb_ld((unsigned*)(CTLP + CW_BAR) + XB_XCNT(j)); ok &= (j < 8u) ? (c_ == G_ / 8u) : (c_ == 0u); }
            MISC[18] = LOCAL_SEAMS ? ok : 0u; MISC[20] = G_ / 8u; MISC[21] = 2u; }
        __syncthreads();
    }

    for (int l = 0; l < DEPTH; ++l) {
        const int pb = 1 + l * NPL;
#define FFN_PHASES(p0, NRM, WGU, WD, BASE0) \
        if (IN(pb + (p0))) { IDS if (!ST_NORM) nv_norm_rows((BASE0), PIN(NRM) + l * DM, WSB(WS_XN), M, gw, NGW, lane); } \
        if (!ST_NORM) SEAM(pb + (p0)); \
        if (IN(pb + (p0) + 1)) { IDS pg8::Gemm g{WSB(WS_XN), WL(l) + (WGU), M, 2 * FF, DM, DM, DM}; pg8::StaticOrder S; S.init(M, 2 * FF, G, cv); \
            if (ST_SWIGLU) { RCACHE_DEF(32, WSF(WS_STATS), 1.0f / 2048.0f) pg8::EpiSwiglu E{WSB(WS_HID), FF, ST_NORM ? WSF(WS_STATS) : nullptr, rc_}; GEMM_PH(pg8::EpiSwiglu); } \
            else { pg8::EpiBf16 E{WSB(WS_GU), 2 * FF}; GEMM_PH(pg8::EpiBf16); } } \
        if (IN(pb + (p0) + 1) && REPS((p0) + 1) == 2) { IDS pg8::Gemm g{WSB(WS_XN), WL(l) + (WGU), M, 2 * FF, DM, DM, DM}; pg8::StaticOrder S; S.init(M, 2 * FF, G, cv); \
            RCACHE_DEF(32, WSF(WS_STATS), 1.0f / 2048.0f) pg8::EpiSwiglu E{WSB(WS_HID), FF, ST_NORM ? WSF(WS_STATS) : nullptr, rc_}; GEMM_PH(pg8::EpiSwiglu); } \
        SEAM_L(pb + (p0) + 1); \
        if (IN(pb + (p0) + 2)) { IDS if (!ST_SWIGLU) nv_swiglu(WSB(WS_GU), WSB(WS_HID), gtid, gsize); } \
        if (!ST_SWIGLU) SEAM(pb + (p0) + 2); \
        if (IN(pb + (p0) + 3)) for (int rep = 0; rep < REPS((p0) + 3); ++rep) { IDS pg8::Gemm g{WSB(WS_HID), WL(l) + (WD), M, DM, FF, FF, FF}; pg8::StaticOrder S; S.init(M, DM, G, cv); \
            if (ST_HILO) { pg8::EpiResid3 E{WSB(WS_XN), (ST_HILO == 2) ? nullptr : WSB(WS_LO), WSF(WS_STATS), DM, rep ? 0.0f : 0.5f}; GEMM_PH(pg8::EpiResid3); } \
            else if (ST_NORM) { pg8::EpiResid2 E{rep ? (const float*)HH : (BASE0), HH, WSB(WS_XN), WSF(WS_STATS), DM, rep ? 0.0f : 0.5f}; GEMM_PH(pg8::EpiResid2); } \
            else { pg8::EpiResid E{(BASE0), HH, DM, 0.5f}; GEMM_PH(pg8::EpiResid); } } \
        if ((p0) == 16 && l == DEPTH - 1) SEAM_P(pb + (p0) + 3); else SEAM_L(pb + (p0) + 3);
        FFN_PHASES(0, I_F1N, WO_GU1, WO_D1, ((l == 0) ? PIN(I_X) : (const float*)HH))
        if (IN(pb + 4)) { IDS if (!ST_NORM) nv_norm_rows(HH, PIN(I_MIXN) + l * DM, WSB(WS_XN), M, gw, NGW, lane); }
        if (!ST_NORM) SEAM(pb + 4);
        if (IN(pb + 5)) for (int rep = 0; rep < REPS(5); ++rep) { IDS pg8::Gemm g{WSB(WS_XN), WL(l) + WO_IN, M, NINP, DM, DM, DM}; pg8::StaticOrder S; S.init(M, NINP, G, cv);
            if (ST_MIX) { RCACHE_DEF(32, WSF(WS_STATS), 1.0f / 2048.0f) pg8::EpiMix<32> E{WSB(WS_U), NINP, WSF(WS_STATS), 1.0f / 2048.0f, 0, WSF(WS_COS64), WSF(WS_SIN64), WSF(WS_COS128), WSF(WS_SIN128), WSF(WS_SQ), WSF(WS_SKV), rc_, 1.0f}; GEMM_PH(pg8::EpiMix<32>); }
            else { pg8::EpiBf16 E{WSB(WS_U), NINP}; GEMM_PH(pg8::EpiBf16); } }
        SEAM_P(pb + 5);
        if (IN(pb + 6)) { IDS if (!ST_MIX) nv_mix_post(WSB(WS_U), WSF(WS_COS64), WSF(WS_SIN64), WSF(WS_COS128), WSF(WS_SIN128), PIN(I_QN) + l * 512, PIN(I_KVN) + l * 512, WSB(WS_CQN), WSB(WS_CKVN), gw, NGW, lane); }
        if (!ST_MIX) SEAM(pb + 6);
        if (IN(pb + 7)) for (int rep = 0; rep < REPS(7); ++rep) { IDS
            { const int tid = wave * 64 + fresh_lane();     pg8::Gemm g{ST_MIX ? WSB(WS_U) + UC_CQ : WSB(WS_CQN), WL(l) + WO_UQ, M, NUQP, 512, ST_MIX ? NINP : 512, 512}; pg8::StaticOrder S; S.init(M, NUQP, G, cv);
              if (ST_MIX) { RCACHE_DEF(8, WSF(WS_SQ), 1.0f / 512.0f) pg8::EpiMix<8> E{WSB(WS_QM), NUQP, WSF(WS_SQ), 1.0f / 512.0f, 1, WSF(WS_COS64), WSF(WS_SIN64), WSF(WS_COS128), WSF(WS_SIN128), nullptr, nullptr, rc_, PRESC_MLA ? QS_MLA : 1.0f}; GEMM_PH(pg8::EpiMix<8>); }
              else { pg8::EpiBf16 E{WSB(WS_QM), NUQP}; GEMM_PH(pg8::EpiBf16); } }
            { const int tid = wave * 64 + fresh_lane();     pg8::Gemm g{ST_MIX ? WSB(WS_U) + UC_CKV : WSB(WS_CKVN), WL(l) + WO_UKV, M, NUKV, 512, ST_MIX ? NINP : 512, 512}; pg8::StaticOrder S; S.init(M, NUKV, G, cv);
              if (ST_MIX) { RCACHE_DEF(8, WSF(WS_SKV), 1.0f / 512.0f) pg8::EpiMix<8> E{WSB(WS_KVM), NUKV, WSF(WS_SKV), 1.0f / 512.0f, 2, nullptr, nullptr, nullptr, nullptr, nullptr, nullptr, rc_, 1.0f}; GEMM_PH(pg8::EpiMix<8>); }
              else { pg8::EpiBf16 E{WSB(WS_KVM), NUKV}; GEMM_PH(pg8::EpiBf16); } }
            { const int tid = wave * 64 + fresh_lane();     pg8::Gemm g{ST_NORM ? WSB(WS_MEMB) : WSB(WS_MEMN), WL(l) + WO_CKV, MMEM, 1024, DM, DM, DM}; pg8::StaticOrder S; S.init(MMEM, 1024, G, lok ? (pidx < 4 ? ((pair & 1) * 8 + 2 * pidx + (pair >> 1)) : G) : cv);
              if (ST_NORM) { RCACHE_DEF(8, WSF(WS_MSTAT), 1.0f / 2048.0f) pg8::EpiMix<8> E{WSB(WS_KVC), 1024, WSF(WS_MSTAT), 1.0f / 2048.0f, 2, nullptr, nullptr, nullptr, nullptr, nullptr, nullptr, rc_, 1.0f}; GEMM_PH(pg8::EpiMix<8>); }
              else { pg8::EpiBf16 E{WSB(WS_KVC), 1024}; GEMM_PH(pg8::EpiBf16); } }
            { char* lp = (char*)lds_raw + RING_OFF; gu32* qctr = CTLP + CW_Q + 64 * ((l + DEPTH * rep) * 4 + pair); gu32* gctr = CTLP + CW_Q + 64 * ((8 + l + DEPTH * rep) * 4 + pair);
              const float lam = WSF(WS_LAM)[l], lami = vp->lam_init[l];
              { const int ldr_ = (wave == 0 && fresh_lane() == 0) ? 1 : 0; wg_publish(gctr, ldr_); }
              int cur = pidx, gready = 0; const int nca = NU_CAUSAL / NQG, ndf = nca * 2 / 5, nq = (NU_CAUSAL + NU_DIL) / NQG;
              while (cur < nq) {
                  const int tidu = wave * 64 + fresh_lane();
                  if (tidu == 0) MISC[12] = __hip_atomic_fetch_add(qctr, 1u, RLX_AGENT) + (unsigned)PG;
                  if (cur < ndf) {
                      int qb, bb, hh;
                      if (lok) { qb = 15 - (cur >> 2); bb = pair; hh = cur & 3; } else { qb = 15 - (cur >> 4); bb = (cur >> 2) & 3; hh = cur & 3; }
                      unit_diff(bb, hh, qb, WSB(WS_U), WSF(WS_A1), WSB(WS_Y), PIN(I_DSUB) + l * 128, lam, lami, lp, tidu);
                  } else if (cur < nca) {
                      if (!gready) { wg_wait(gctr, (unsigned)PG, (tidu == 0) ? 1 : 0); gready = 1; }
                      const int c2 = cur - ndf; int qb, bb, hh;
                      if (lok) { qb = 15 - c2 / 6; bb = pair; hh = c2 % 6; } else { qb = 15 - c2 / 24; const int w = c2 % 24; bb = w / 6; hh = w % 6; }
                      unit_mla(bb, hh, qb, WSB(WS_QM), 0, ST_MIX ? 128 : 192, ST_MIX ? 768 : 128, ST_MIX ? 64 : 192, WSB(WS_KVM), WSB(WS_U), WSB(WS_Y), lp, tidu);
                  } else {
                      const int cd = cur - nca; int g, bb, hh, ub;
                      if (lok) { g = cd / 96; const int rem = cd % 96; bb = pair; hh = rem >> 4; ub = rem & 15; }
                      else { g = cd / 384; const int rem = cd % 384, bh = rem >> 4; bb = bh / 6; hh = bh % 6; ub = rem & 15; }
                      unit_dil(g, bb, hh, ub, WSB(WS_U), WSB(WS_OD), WSF(WS_LSE), lp, tidu);
                  }
                  __syncthreads(); cur = __builtin_amdgcn_readfirstlane((int)MISC[12]); __syncthreads();
              } }
        }
        SEAM_P(pb + 7);
        if (IN(pb + 8)) { IDS if (!ST_MIX) nv_mla_post(WSB(WS_QM), WSF(WS_COS64), WSF(WS_SIN64), gw, NGW, lane); }
        if (!ST_MIX) SEAM(pb + 8);
        if (IN(pb + 9)) for (int rep = 0; rep < REPS(9); ++rep) { IDS
            dil_merge(WSB(WS_OD), WSF(WS_LSE), WSB(WS_Y), pair * (SEQ * 96) + pidx * (NWAVES * 64) + tid, lok ? (pair + 1) * (SEQ * 96) : M * 96, PG * (NWAVES * 64));
        }
        SEAM_P(pb + 9);
        if (IN(pb + 11)) for (int rep = 0; rep < REPS(11); ++rep) { IDS pg8::Gemm g{WSB(WS_Y), WL(l) + WO_OUT, M, DM, DM, DM, DM}; pg8::StaticOrder S; S.init(M, DM, G, cv);
            if (ST_HILO) { pg8::EpiResid3 E{WSB(WS_XN), (ST_HILO == 2) ? nullptr : WSB(WS_LO), WSF(WS_STATS), DM, rep ? 0.0f : 1.0f}; GEMM_PH(pg8::EpiResid3); }
            else if (ST_NORM) { pg8::EpiResid2 E{HH, HH, WSB(WS_XN), WSF(WS_STATS), DM, rep ? 0.0f : 1.0f}; GEMM_PH(pg8::EpiResid2); }
            else { pg8::EpiResid E{HH, HH, DM, 1.0f}; GEMM_PH(pg8::EpiResid); } }
        SEAM_L(pb + 11);
        if (IN(pb + 12)) { IDS if (!ST_NORM) { nv_norm_rows(HH, PIN(I_CRN) + l * DM, WSB(WS_XN), M, gw, NGW, lane); nv_norm_rows(PIN(I_MEM), PIN(I_MEMN) + l * DM, WSB(WS_MEMN), MMEM, gw, NGW, lane); } }
        if (!ST_NORM) SEAM(pb + 12);
        if (IN(pb + 13)) for (int rep = 0; rep < REPS(13); ++rep) { IDS
            { pg8::Gemm g{WSB(WS_XN), WL(l) + WO_CQ, M, 512, DM, DM, DM}; pg8::StaticOrder S; S.init(M, 512, G, cv);
              if (ST_NORM) { RCACHE_DEF(32, WSF(WS_STATS), 1.0f / 2048.0f) pg8::EpiMix<32> E{WSB(WS_CQ2), 512, WSF(WS_STATS), 1.0f / 2048.0f, 2, nullptr, nullptr, nullptr, nullptr, nullptr, nullptr, rc_, PRESC_CROSS ? QS_CROSS : 1.0f}; GEMM_PH(pg8::EpiMix<32>); }
              else { pg8::EpiBf16 E{WSB(WS_CQ2), 512}; GEMM_PH(pg8::EpiBf16); } }
        }
        SEAM_L(pb + 13);
        if (IN(pb + 14)) for (int rep = 0; rep < REPS(14); ++rep) { IDS char* lp = (char*)lds_raw + RING_OFF; for (int u = lok ? (32 * xcc + xrank) : bx; u < (M / 256) * 4; u += G) { const int tidu = wave * 64 + fresh_lane(); unit_cross(u >> 2, u & 3, WSB(WS_CQ2), WSB(WS_KVC), WSB(WS_OC), lp, tidu); } }
        SEAM_L(pb + 14);
        if (IN(pb + 15)) for (int rep = 0; rep < REPS(15); ++rep) { IDS pg8::Gemm g{WSB(WS_OC), WL(l) + WO_CO, M, DM, 512, 512, 512}; pg8::StaticOrder S; S.init(M, DM, G, cv);
            if (ST_HILO) { pg8::EpiResid3 E{WSB(WS_XN), (ST_HILO == 2) ? nullptr : WSB(WS_LO), WSF(WS_STATS), DM, rep ? 0.0f : 1.0f}; GEMM_PH(pg8::EpiResid3); }
            else if (ST_NORM) { pg8::EpiResid2 E{HH, HH, WSB(WS_XN), WSF(WS_STATS), DM, rep ? 0.0f : 1.0f}; GEMM_PH(pg8::EpiResid2); }
            else { pg8::EpiResid E{HH, HH, DM, 1.0f}; GEMM_PH(pg8::EpiResid); } }
        SEAM_L(pb + 15);
        FFN_PHASES(16, I_F2N, WO_GU2, WO_D2, ((const float*)HH))
#undef FFN_PHASES
    }
    if (IN(PH_TOTAL - 1)) { IDS
        if (ST_HILO) final_norm_hilo(WSB(WS_XN), (ST_HILO == 2) ? nullptr : WSB(WS_LO), HH, PIN(I_FINN), pair * SEQ + pidx * NWAVES + wave, lok ? (pair + 1) * SEQ : M, PG * NWAVES, lane);
        else nv_final_norm(HH, PIN(I_FINN), gw, NGW, lane); }
#undef IN
#undef SEAM
#undef IDS
#undef PIN
#undef WS
#undef CTLP
#undef HH
#undef WSB
#undef WSF
#undef WL
#undef GEMM_PH
#undef RCACHE_DEF
}

#ifndef MK_ONE_LAUNCH
#define MK_ONE_LAUNCH 1
#endif
extern "C" void kernel_launch(void* const* d_in, const int* in_sizes, int n_in, void* d_out, int out_size, void* d_ws, size_t ws_size, hipStream_t stream) {
    static int grid = 0;
    if (grid == 0) {
        if (n_in != 26 || in_sizes[0] != M * DM || out_size != M * DM || ws_size < WS_END) {
            fprintf(stderr, "kernel_launch: shape mismatch: n_in %d in0 %d out %d ws %zu (need %zu); not((l == 0) ? PIN(I_X) : (const float*)H)g launched\n", n_in, n_in > 0 ? in_sizes[0] : -1, out_size, ws_size, (size_t)WS_END); grid = -1; return; }
        int dev = 0, cus = 0, per_cu = 0;
        if (hipGetDevice(&dev) != hipSuccess || hipDeviceGetAttribute(&cus, hipDeviceAttributeMultiprocessorCount, dev) != hipSuccess) { grid = -1; return; }
        if (hipFuncSetAttribute((const void*)mk_fwd, hipFuncAttributeMaxDynamicSharedMemorySize, LDS_BYTES) != hipSuccess) { fprintf(stderr, "kernel_launch: hipFuncSetAttribute failed\n"); grid = -1; return; }
        if (hipOccupancyMaxActiveBlocksPerMultiprocessor(&per_cu, (const void*)mk_fwd, NWAVES * 64, LDS_BYTES) != hipSuccess || per_cu < 1) fprintf(stderr, "kernel_launch: occupancy query says %d\n", per_cu);
        (void)hipGetLastError();
        grid = cus;
    }
    if (grid < 0) return;
    if (hipMemsetAsync((char*)d_ws + WS_CTL, 0, CTL_ZERO_BYTES, stream) != hipSuccess) return;
    Params p{};
    for (int i = 0; i < 26; ++i) p.in[i] = (const float*)d_in[i];
    p.out = (float*)d_out; p.ws = (unsigned char*)d_ws;
    for (int i = 0; i < 32; ++i) p.inv64[i] = (float)(1.0 / pow(10000.0, (double)(2 * i) / 64.0));
    for (int i = 0; i < 64; ++i) p.inv128[i] = (float)(1.0 / pow(10000.0, (double)(2 * i) / 128.0));
    for (int l = 0; l < DEPTH; ++l) p.lam_init[l] = (float)(0.8 - 0.6 * exp(-0.3 * (double)l));
    p.pad = 0;
#if MK_ONE_LAUNCH
    p.ph_lo = 0; p.ph_hi = PH_TOTAL; p.use_bar = 1;
    hipLaunchKernelGGL(mk_fwd, dim3(grid), dim3(NWAVES * 64), LDS_BYTES, stream, p);
#else
    p.use_bar = 0;
    for (int ph = 0; ph < PH_TOTAL; ++ph) { p.ph_lo = ph; p.ph_hi = ph + 1; hipLaunchKernelGGL(mk_fwd, dim3(grid), dim3(NWAVES * 64), LDS_BYTES, stream, p); }
#endif
    const hipError_t le = hipPeekAtLastError();
    if (le != hipSuccess) fprintf(stderr, "kernel_launch: launch failed: %s\n", hipGetErrorName(le));
}
```

```cpp
#include <hip/hip_runtime.h>
#include <cstdio>
#include <cstdint>
#include <cmath>
#ifndef PRESC_DIFF
#define PRESC_DIFF 1
#endif
#ifndef PRESC_CROSS
#define PRESC_CROSS 1
#endif
#ifndef PRESC_MLA
#define PRESC_MLA 1
#endif
#define QS_LOG2E 1.4426950408889634f
#define QS_DIFF (0.125f * QS_LOG2E)
#define QS_MLA (0.07216878364870322f * QS_LOG2E)
#define QS_CROSS (0.08838834764831845f * QS_LOG2E)
#define QS_DIL (0.08838834764831845f * QS_LOG2E)
#ifndef PRESC_DIL
#define PRESC_DIL 1
#endif
namespace pg8 {
#define PG8_LAS __attribute__((address_space(3)))
typedef unsigned short bf16_t;
typedef short bf16x8 __attribute__((ext_vector_type(8)));
typedef float f32x4 __attribute__((ext_vector_type(4)));
typedef unsigned u32x4 __attribute__((ext_vector_type(4)));
constexpr int BM = 256, BK = 64, HALF = 128, HTB = HALF * BK * 2  , STAGE_BYTES = 8 * HTB, NXCD = 8, WGM = 8;

__host__ __device__ __forceinline__ int lds_byte(int r, int c) { const int st = (r >> 4) * 2 + (c >> 5), rr = r & 15, cc = c & 31, ob = rr * 64 + cc * 2; return st * 1024 + (ob ^ (((ob >> 9) & 1) << 5)); }
__host__ __device__ __forceinline__ void stage_rc(int b, int& R, int& C) { const int st = b / 1024, sb = b % 1024, swz = sb ^ (((sb >> 9) & 1) << 5); R = (st >> 1) * 16 + swz / 64; C = (st & 1) * 32 + (swz % 64) / 2; }
__host__ __device__ __forceinline__ int perm32(int rho) { const int n = rho >> 4, i = rho & 15; return 8 * (i >> 2) + 4 * n + (i & 3); }

struct Unit { int pm, pn; };
struct Gemm { const bf16_t* A; const bf16_t* Bt; int M, N, K, lda, ldb; };

struct StaticOrder {
    int nM, nN, nwg, G, c;
    __host__ __device__ __forceinline__ void init(int M, int N, int G_, int c_) { nM = M / BM; nN = N / BM; nwg = nM * nN; G = G_; c = c_; }
    __host__ __device__ __forceinline__ bool next(int i, Unit& u) const {
        const long L = (long)i * G + c; if (L >= nwg) return false;
        int wgid = (int)L; { const int q = nwg / NXCD, r = nwg % NXCD, xcd = wgid % NXCD, off = wgid / NXCD; wgid = (xcd < r ? xcd * (q + 1) : r * (q + 1) + (xcd - r) * q) + off; }
        const int nig = WGM * nN, gid = wgid / nig, fm = gid * WGM, gsz = (nM - fm) < WGM ? (nM - fm) : WGM;
        u.pm = fm + ((wgid % nig) % gsz); u.pn = (wgid % nig) / gsz; return true;
    }
    __device__ __forceinline__ void a_ready(const Unit&) const {}
    __device__ __forceinline__ void done(const Unit&) const {}
};

__device__ __forceinline__ unsigned cvt_pk_bf16(float lo, float hi) { unsigned r; asm volatile("v_cvt_pk_bf16_f32 %0, %1, %2" : "=v"(r) : "v"(lo), "v"(hi)); return r; }
typedef float f32x2 __attribute__((ext_vector_type(2)));
struct EpiBf16 {
    static constexpr bool PERM = true, AFTER_DRAIN = false;
    bf16_t* O; int ldc;
    __device__ __forceinline__ void operator()(const f32x4 (&acc)[2][2][4][2], const Unit& u, int wr, int wc, int fr, int fq) const {
        const int row0 = u.pm * BM + wr * 64 + fr, col0 = u.pn * BM + wc * 32 + 8 * fq;
#pragma unroll
        for (int ai = 0; ai < 2; ++ai)
#pragma unroll
            for (int m = 0; m < 4; ++m) { bf16_t* rowp = O + (size_t)(row0 + ai * HALF + m * 16) * ldc + col0;
#pragma unroll
                for (int bj = 0; bj < 2; ++bj) { const f32x4 v0 = acc[ai][bj][m][0], v1 = acc[ai][bj][m][1];
                    u32x4 w; w.x = cvt_pk_bf16(v0[0], v0[1]); w.y = cvt_pk_bf16(v0[2], v0[3]); w.z = cvt_pk_bf16(v1[0], v1[1]); w.w = cvt_pk_bf16(v1[2], v1[3]);
                    *(u32x4*)(rowp + bj * HALF) = w; } }
    }
};
struct EpiResid {
    static constexpr bool PERM = false, AFTER_DRAIN = false;
    const float* base; float* out; int ldc; float scale;
    __device__ __forceinline__ void operator()(const f32x4 (&acc)[2][2][4][2], const Unit& u, int wr, int wc, int fr, int fq) const {
        const int col0 = u.pn * BM + wc * 32 + 4 * fq;
#pragma unroll
        for (int ai = 0; ai < 2; ++ai)
#pragma unroll
            for (int m = 0; m < 4; ++m) { const size_t off = (size_t)(u.pm * BM + ai * HALF + wr * 64 + m * 16 + fr) * ldc + col0;
#pragma unroll
                for (int bj = 0; bj < 2; ++bj)
#pragma unroll
                    for (int n = 0; n < 2; ++n) { const f32x4 bs = *(const f32x4*)(base + off + bj * HALF + n * 16); *(f32x4*)(out + off + bj * HALF + n * 16) = bs + acc[ai][bj][m][n] * scale; }
                asm volatile("" ::: "memory"); }
    }
};

__device__ __forceinline__ float bperm_f(int src_lane, float v) { return __builtin_bit_cast(float, __builtin_amdgcn_ds_bpermute(src_lane << 2, __builtin_bit_cast(int, v))); }
template <int NPART> __device__ __forceinline__ void row_rstd8(const float* S, int row0  , int fr, int fq, float inv_n, float eps, float (&rs)[2][4]) {
    float mine[2];
#pragma unroll
    for (int j = 0; j < 2; ++j) { const f32x4* p = (const f32x4*)(S + (size_t)(row0 + 128 * (fq >> 1) + 16 * (2 * (fq & 1) + j) + fr) * NPART); float s = 0.f;
#pragma unroll
        for (int i = 0; i < NPART / 4; ++i) { const f32x4 v = p[i]; s += (v.x + v.y) + (v.z + v.w); }
        mine[j] = 1.0f / __builtin_sqrtf(s * inv_n + eps); }
#pragma unroll
    for (int ai = 0; ai < 2; ++ai)
#pragma unroll
        for (int mh = 0; mh < 2; ++mh) { const int src = fr + 16 * (2 * ai + mh); rs[ai][2 * mh] = bperm_f(src, mine[0]); rs[ai][2 * mh + 1] = bperm_f(src, mine[1]); }
}
struct RstdCache { unsigned tab; int pm; };
template <int NPART> __device__ __forceinline__ void rstd8_cached(const RstdCache& rc, const float* S, const Unit& u, int wr, int fr, int fq, float inv_n, float eps, float (&rs)[2][4]) {
    if (u.pm == rc.pm) {
#pragma unroll
        for (int ai = 0; ai < 2; ++ai)
#pragma unroll
            for (int m = 0; m < 4; ++m) rs[ai][m] = ((const PG8_LAS float*)(size_t)rc.tab)[ai * HALF + wr * 64 + m * 16 + fr];
    } else row_rstd8<NPART>(S, u.pm * BM + wr * 64, fr, fq, inv_n, eps, rs);
}
template <int NPART> __device__ __forceinline__ RstdCache rstd_cache_fill(PG8_LAS float* tab, const float* S, int pm, int tid, float inv_n, float eps) {
    if (tid < 256) { const f32x4* p = (const f32x4*)(S + (size_t)(pm * BM + tid) * NPART); float s = 0.f;
#pragma unroll
        for (int i = 0; i < NPART / 4; ++i) { const f32x4 v = p[i]; s += (v.x + v.y) + (v.z + v.w); }
        tab[tid] = 1.0f / __builtin_sqrtf(s * inv_n + eps); }
    __syncthreads();
    RstdCache rc; rc.tab = (unsigned)(size_t)tab; rc.pm = pm; return rc;
}
struct EpiSwiglu {
    static constexpr bool PERM = true, AFTER_DRAIN = false;
    bf16_t* O; int ldc; const float* S; RstdCache rc;
    __device__ __forceinline__ void operator()(const f32x4 (&acc)[2][2][4][2], const Unit& u, int wr, int wc, int fr, int fq) const {
        float rs[2][4];
        if (S) rstd8_cached<32>(rc, S, u, wr, fr, fq, 1.0f / 2048.0f, 1e-6f, rs);
        else {
#pragma unroll
            for (int a = 0; a < 2; ++a)
#pragma unroll
                for (int m = 0; m < 4; ++m) rs[a][m] = 1.0f; }
        const int row0 = u.pm * BM + wr * 64 + fr, col0 = u.pn * HALF + wc * 32 + 8 * fq;
#pragma unroll
        for (int ai = 0; ai < 2; ++ai)
#pragma unroll
            for (int m = 0; m < 4; ++m) { const float r = rs[ai][m], rn = r * -1.4426950408889634f, rr = r * r; float h[8];
#pragma unroll
                for (int n = 0; n < 2; ++n)
#pragma unroll
                    for (int hp = 0; hp < 2; ++hp) { const f32x2 ag = {acc[ai][0][m][n][2 * hp], acc[ai][0][m][n][2 * hp + 1]}, au = {acc[ai][1][m][n][2 * hp], acc[ai][1][m][n][2 * hp + 1]};
                        const f32x2 t = ag * rn; f32x2 e; e.x = __builtin_amdgcn_exp2f(t.x); e.y = __builtin_amdgcn_exp2f(t.y);
                        const f32x2 d = e + 1.0f; f32x2 sg; sg.x = __builtin_amdgcn_rcpf(d.x); sg.y = __builtin_amdgcn_rcpf(d.y);
                        const f32x2 hh = (ag * au) * (sg * rr);
                        h[4 * n + 2 * hp] = hh.x; h[4 * n + 2 * hp + 1] = hh.y; }
                u32x4 w; w.x = cvt_pk_bf16(h[0], h[1]); w.y = cvt_pk_bf16(h[2], h[3]); w.z = cvt_pk_bf16(h[4], h[5]); w.w = cvt_pk_bf16(h[6], h[7]);
                *(u32x4*)(O + (size_t)(row0 + ai * HALF + m * 16) * ldc + col0) = w; }
    }
};
struct EpiResid2 {
    static constexpr bool PERM = true, AFTER_DRAIN = false;
    const float* base; float* out; bf16_t* HB; float* S; int ldc; float scale;
    __device__ __forceinline__ void operator()(const f32x4 (&acc)[2][2][4][2], const Unit& u, int wr, int wc, int fr, int fq) const {
        const int col0 = u.pn * BM + wc * 32 + 8 * fq, lane = fr + 16 * fq;
#pragma unroll
        for (int ai = 0; ai < 2; ++ai)
#pragma unroll
            for (int m = 0; m < 4; ++m) { const int row = u.pm * BM + ai * HALF + wr * 64 + m * 16 + fr; const size_t off = (size_t)row * ldc + col0; float ss = 0.f;
#pragma unroll
                for (int bj = 0; bj < 2; ++bj) { const f32x4 b0 = *(const f32x4*)(base + off + bj * HALF), b1 = *(const f32x4*)(base + off + bj * HALF + 4);
                    const f32x4 v0 = b0 + acc[ai][bj][m][0] * scale, v1 = b1 + acc[ai][bj][m][1] * scale;
                    *(f32x4*)(out + off + bj * HALF) = v0; *(f32x4*)(out + off + bj * HALF + 4) = v1;
                    ss += (v0.x * v0.x + v0.y * v0.y) + (v0.z * v0.z + v0.w * v0.w) + (v1.x * v1.x + v1.y * v1.y) + (v1.z * v1.z + v1.w * v1.w);
                    u32x4 w; w.x = cvt_pk_bf16(v0.x, v0.y); w.y = cvt_pk_bf16(v0.z, v0.w); w.z = cvt_pk_bf16(v1.x, v1.y); w.w = cvt_pk_bf16(v1.z, v1.w); *(u32x4*)(HB + off + bj * HALF) = w; }
                ss += bperm_f(lane ^ 16, ss); ss += bperm_f(lane ^ 32, ss);
                if (fq == 0) S[(size_t)row * 32 + 4 * u.pn + wc] = ss;
                asm volatile("" ::: "memory"); }
    }
};
struct EpiResid3 {
    static constexpr bool PERM = true, AFTER_DRAIN = false;
    bf16_t* HB; bf16_t* LO; float* S; int ldc; float scale;
    static __device__ __forceinline__ float lo16(unsigned u) { return __builtin_bit_cast(float, u << 16); }
    static __device__ __forceinline__ float hi16(unsigned u) { return __builtin_bit_cast(float, u & 0xffff0000u); }
    __device__ __forceinline__ void operator()(const f32x4 (&acc)[2][2][4][2], const Unit& u, int wr, int wc, int fr, int fq) const {
        const int col0 = u.pn * BM + wc * 32 + 8 * fq, lane = fr + 16 * fq;
#pragma unroll
        for (int ai = 0; ai < 2; ++ai)
#pragma unroll
            for (int m = 0; m < 4; ++m) { const int row = u.pm * BM + ai * HALF + wr * 64 + m * 16 + fr; const size_t off = (size_t)row * ldc + col0; float ss = 0.f;
#pragma unroll
                for (int bj = 0; bj < 2; ++bj) { const u32x4 h = *(const u32x4*)(HB + off + bj * HALF); u32x4 l = {0u, 0u, 0u, 0u}; if (LO) l = *(const u32x4*)(LO + off + bj * HALF);
                    float v[8];
#pragma unroll
                    for (int i = 0; i < 4; ++i) { v[2 * i] = (lo16(h[i]) + lo16(l[i])) + acc[ai][bj][m][i >> 1][(2 * i) & 3] * scale; v[2 * i + 1] = (hi16(h[i]) + hi16(l[i])) + acc[ai][bj][m][i >> 1][(2 * i + 1) & 3] * scale; }
                    u32x4 wh, wl;
#pragma unroll
                    for (int i = 0; i < 4; ++i) { ss += v[2 * i] * v[2 * i] + v[2 * i + 1] * v[2 * i + 1]; const unsigned p = cvt_pk_bf16(v[2 * i], v[2 * i + 1]); wh[i] = p;
                        wl[i] = cvt_pk_bf16(v[2 * i] - lo16(p), v[2 * i + 1] - hi16(p)); }
                    *(u32x4*)(HB + off + bj * HALF) = wh; if (LO) *(u32x4*)(LO + off + bj * HALF) = wl; }
                ss += bperm_f(lane ^ 16, ss); ss += bperm_f(lane ^ 32, ss);
                if (fq == 0) S[(size_t)row * 32 + 4 * u.pn + wc] = ss;
                asm volatile("" ::: "memory"); }
    }
};
__host__ __device__ __forceinline__ int rope_perm64(int c) { return ((c >> 5) & 1) * 128 + (c >> 6) * 32 + (c & 31); }
__host__ __device__ __forceinline__ int rope_perm128(int c) { return ((c >> 6) & 1) * 128 + (c >> 7) * 64 + (c & 63); }
__host__ __device__ __forceinline__ int win_kind(int t) { return t < 4 ? 2 : t < 6 ? 0 : t < 10 ? 1 : t == 10 ? 2 : t < 17 ? 3 : 0; }
template <int NPART> struct EpiMix {
    static constexpr bool PERM = true, AFTER_DRAIN = false;
    bf16_t* O; int ldc; const float* S; float inv_n; int mode;
    const float* cos64; const float* sin64; const float* cos128; const float* sin128; float* SQ; float* SKV; RstdCache rc; float osc;
    __device__ __forceinline__ void operator()(const f32x4 (&acc)[2][2][4][2], const Unit& u, int wr, int wc, int fr, int fq) const {
        float rs[2][4]; rstd8_cached<NPART>(rc, S, u, wr, fr, fq, inv_n, 1e-6f, rs);
        const float osc_ = (mode == 0) ? ((PRESC_DIFF != 0 && u.pn < 2) ? QS_DIFF : (PRESC_DIL != 0 && u.pn >= 11 && u.pn <= 13) ? QS_DIL : 1.0f) : osc;
        const int kind = (mode == 0) ? win_kind(u.pn) : (mode == 1) ? (u.pn < 3 ? 0 : 2) : 0;
        const int row0 = u.pm * BM + wr * 64 + fr, lane = fr + 16 * fq;
        if (kind < 2) {
            const int col0 = u.pn * BM + wc * 32 + 8 * fq;
#pragma unroll
            for (int ai = 0; ai < 2; ++ai)
#pragma unroll
                for (int m = 0; m < 4; ++m) { const int row = row0 + ai * HALF + m * 16; const float r = rs[ai][m] * osc_; float ss = 0.f;
#pragma unroll
                    for (int bj = 0; bj < 2; ++bj) { const f32x4 v0 = acc[ai][bj][m][0] * r, v1 = acc[ai][bj][m][1] * r;
                        ss += (v0[0] * v0[0] + v0[1] * v0[1]) + (v0[2] * v0[2] + v0[3] * v0[3]) + (v1[0] * v1[0] + v1[1] * v1[1]) + (v1[2] * v1[2] + v1[3] * v1[3]);
                        u32x4 w; w.x = cvt_pk_bf16(v0[0], v0[1]); w.y = cvt_pk_bf16(v0[2], v0[3]); w.z = cvt_pk_bf16(v1[0], v1[1]); w.w = cvt_pk_bf16(v1[2], v1[3]);
                        *(u32x4*)(O + (size_t)row * ldc + col0 + bj * HALF) = w; }
                    if (kind == 1) { ss += bperm_f(lane ^ 16, ss); ss += bperm_f(lane ^ 32, ss);
                        if (fq == 0) { float* dst = (u.pn < 8) ? SQ : SKV; dst[(size_t)row * 8 + 4 * (u.pn & 1) + wc] = ss; } } }
        } else {
            const bool r64 = (kind == 2);
            const int hd = r64 ? wc : (wc >> 1), idx = r64 ? 8 * fq : 32 * (wc & 1) + 8 * fq, hw = r64 ? 64 : 128, tw = r64 ? 32 : 64;
            const float* ct = r64 ? cos64 : cos128; const float* st = r64 ? sin64 : sin128;
            const int colb = u.pn * BM + hd * hw + idx;
#pragma unroll
            for (int ai = 0; ai < 2; ++ai)
#pragma unroll
                for (int m = 0; m < 4; ++m) { const int row = row0 + ai * HALF + m * 16; const float r = rs[ai][m] * osc_;
                    const f32x4 c0 = *(const f32x4*)(ct + (size_t)row * tw + idx), c1 = *(const f32x4*)(ct + (size_t)row * tw + idx + 4);
                    const f32x4 s0 = *(const f32x4*)(st + (size_t)row * tw + idx), s1 = *(const f32x4*)(st + (size_t)row * tw + idx + 4);
                    const f32x4 a0 = acc[ai][0][m][0] * r, a1 = acc[ai][0][m][1] * r, b0 = acc[ai][1][m][0] * r, b1 = acc[ai][1][m][1] * r;
                    const f32x4 y10 = a0 * c0 - b0 * s0, y11 = a1 * c1 - b1 * s1, y20 = a0 * s0 + b0 * c0, y21 = a1 * s1 + b1 * c1;
                    u32x4 w1, w2; w1.x = cvt_pk_bf16(y10[0], y10[1]); w1.y = cvt_pk_bf16(y10[2], y10[3]); w1.z = cvt_pk_bf16(y11[0], y11[1]); w1.w = cvt_pk_bf16(y11[2], y11[3]);
                    w2.x = cvt_pk_bf16(y20[0], y20[1]); w2.y = cvt_pk_bf16(y20[2], y20[3]); w2.z = cvt_pk_bf16(y21[0], y21[1]); w2.w = cvt_pk_bf16(y21[2], y21[3]);
                    *(u32x4*)(O + (size_t)row * ldc + colb) = w1; *(u32x4*)(O + (size_t)row * ldc + colb + hw / 2) = w2; }
        }
    }
};

template <class Epi, class Sched, bool ALIGN_EPI = false, bool SP2 = false>
__device__ __forceinline__ void gemm_phase(PG8_LAS unsigned char* lds, const Gemm g, const Sched& S, const Epi& E, const int tid  ) {
    const int wid = __builtin_amdgcn_readfirstlane(tid >> 6), lane = tid & 63, wr = wid >> 2, wc = wid & 3, fr = lane & 15, fq = lane >> 4;
    const int K = g.K, nt = K / BK;
    unsigned voffA[2], voffB[2];
#pragma unroll
    for (int i = 0; i < 2; ++i) { int R, C; stage_rc(tid * 16 + i * 8192, R, C); const int Rb = Epi::PERM ? ((R & ~31) + perm32(R & 31)) : R;
        voffA[i] = (unsigned)(R * g.lda + C) * 2u; voffB[i] = (unsigned)(Rb * g.ldb + C) * 2u; }
    const size_t kstep = (size_t)(BK * 2);
    const size_t hstepA = (size_t)HALF * g.lda * 2, hstepB = (size_t)HALF * g.ldb * 2;
    const size_t tstepA = 2 * hstepA, tstepB = 2 * hstepB;
    const unsigned ldsw = (unsigned)wid * 1024u;
    const int aoff = lds_byte(wr * 64 + fr, fq * 8), boff = lds_byte(wc * 32 + fr, fq * 8);
#define PG8_SA(b, h) (((b) * 2 + (h)) * HTB)
#define PG8_SB(b, h) ((4 + (b) * 2 + (h)) * HTB)
#define PG8_STAGE(bufoff, gbase, voff) do { _Pragma("unroll") for (int _i = 0; _i < 2; ++_i) \
        __builtin_amdgcn_global_load_lds((const unsigned*)((const char*)(gbase) + (voff)[_i]), (PG8_LAS unsigned*)(lds + (bufoff) + ldsw + _i * 8192), 16, 0, 0); } while (0)
#define PG8_LDA(dst, b, h) do { _Pragma("unroll") for (int m = 0; m < 4; ++m) _Pragma("unroll") for (int k = 0; k < 2; ++k) dst[m][k] = *(const PG8_LAS bf16x8*)(lds + PG8_SA(b, h) + aoff + m * 2048 + k * 1024); } while (0)
#define PG8_LDB(dst, b, h) do { _Pragma("unroll") for (int n = 0; n < 2; ++n) _Pragma("unroll") for (int k = 0; k < 2; ++k) dst[n][k] = *(const PG8_LAS bf16x8*)(lds + PG8_SB(b, h) + boff + n * 2048 + k * 1024); } while (0)
#define PG8_MMA(ai, bj, At, Bt) do { __builtin_amdgcn_s_setprio(1); _Pragma("unroll") for (int m = 0; m < 4; ++m) _Pragma("unroll") for (int n = 0; n < 2; ++n) _Pragma("unroll") for (int k = 0; k < 2; ++k) \
        acc[ai][bj][m][n] = __builtin_amdgcn_mfma_f32_16x16x32_bf16(Bt[n][k], At[m][k], acc[ai][bj][m][n], 0, 0, 0); __builtin_amdgcn_s_setprio(0); } while (0)
#define PG8_WAIT_V(n) asm volatile("s_waitcnt vmcnt(" #n ")" ::: "memory")
#define PG8_WAIT_L(n) asm volatile("s_waitcnt lgkmcnt(" #n ")" ::: "memory")
#define PG8_BAR __builtin_amdgcn_s_barrier()
#define PG8_SCHED __builtin_amdgcn_sched_barrier(0)
    Unit cur, nxt; int ui = 0;
    if (!S.next(0, cur)) return;
    f32x4 acc[2][2][4][2];
#pragma unroll
    for (int a = 0; a < 2; ++a)
#pragma unroll
        for (int b = 0; b < 2; ++b)
#pragma unroll
            for (int m = 0; m < 4; ++m)
#pragma unroll
                for (int n = 0; n < 2; ++n) acc[a][b][m][n] = (f32x4){0.f, 0.f, 0.f, 0.f};
    bf16x8 At[4][2], B0[2][2], B1[2][2];
    const char* cA = (const char*)g.A + (size_t)cur.pm * tstepA; const char* cB = (const char*)g.Bt + (size_t)cur.pn * tstepB;
    S.a_ready(cur);
    if constexpr (SP2) {
        PG8_STAGE(PG8_SB(0, 0), cB, voffB); PG8_STAGE(PG8_SB(0, 1), cB + hstepB, voffB); PG8_STAGE(PG8_SA(0, 0), cA, voffA); PG8_STAGE(PG8_SA(0, 1), cA + hstepA, voffA);
        if (wr == 1) PG8_BAR;
        PG8_WAIT_V(2); PG8_BAR;
        PG8_STAGE(PG8_SB(1, 0), cB + kstep, voffB); PG8_STAGE(PG8_SA(1, 0), cA + kstep, voffA); PG8_STAGE(PG8_SB(1, 1), cB + hstepB + kstep, voffB);
        PG8_WAIT_V(6); PG8_BAR;
    } else {
        PG8_STAGE(PG8_SB(0, 0), cB, voffB); PG8_STAGE(PG8_SA(0, 0), cA, voffA); PG8_STAGE(PG8_SB(0, 1), cB + hstepB, voffB); PG8_STAGE(PG8_SA(0, 1), cA + hstepA, voffA);
        if (wr == 1) PG8_BAR;
        PG8_WAIT_V(4); PG8_BAR;
        PG8_STAGE(PG8_SB(1, 0), cB + kstep, voffB); PG8_STAGE(PG8_SA(1, 0), cA + kstep, voffA); PG8_STAGE(PG8_SB(1, 1), cB + hstepB + kstep, voffB);
        PG8_WAIT_V(6); PG8_BAR;
    }
    for (;;) {
        const bool has_next = S.next(ui + 1, nxt);
        const char* nA = has_next ? (const char*)g.A + (size_t)nxt.pm * tstepA : cA; const char* nB = has_next ? (const char*)g.Bt + (size_t)nxt.pn * tstepB : cB;
        for (int t = 0; t < nt; t += 2) {
            const bool last = (t == nt - 2);
            const char* a1 = cA + (size_t)(t + 1) * kstep;
            const char* a2 = last ? nA : cA + (size_t)(t + 2) * kstep; const char* b2 = last ? nB : cB + (size_t)(t + 2) * kstep;
            const char* a3 = a2 + kstep; const char* b3 = b2 + kstep;
            if (last && has_next) S.a_ready(nxt);
            if constexpr (SP2) {
            PG8_LDB(B0, 0, 0); PG8_LDB(B1, 0, 1); PG8_SCHED; PG8_LDA(At, 0, 0); PG8_STAGE(PG8_SA(1, 1), a1 + hstepA, voffA);
            PG8_WAIT_V(8); PG8_WAIT_L(0); PG8_BAR; PG8_MMA(0, 0, At, B0); PG8_MMA(0, 1, At, B1); PG8_BAR; PG8_SCHED;
            PG8_LDA(At, 0, 1); PG8_STAGE(PG8_SB(0, 0), b2, voffB); PG8_STAGE(PG8_SB(0, 1), b2 + hstepB, voffB); PG8_STAGE(PG8_SA(0, 0), a2, voffA);
            PG8_WAIT_V(8); PG8_WAIT_L(0); PG8_BAR; PG8_MMA(1, 0, At, B0); PG8_MMA(1, 1, At, B1); PG8_BAR; PG8_SCHED;
            PG8_LDB(B0, 1, 0); PG8_LDB(B1, 1, 1); PG8_SCHED; PG8_LDA(At, 1, 0); PG8_STAGE(PG8_SA(0, 1), a2 + hstepA, voffA);
            PG8_WAIT_V(8); PG8_WAIT_L(0); PG8_BAR; PG8_MMA(0, 0, At, B0); PG8_MMA(0, 1, At, B1); PG8_BAR; PG8_SCHED;
            PG8_LDA(At, 1, 1); PG8_STAGE(PG8_SB(1, 0), b3, voffB); PG8_STAGE(PG8_SB(1, 1), b3 + hstepB, voffB); PG8_STAGE(PG8_SA(1, 0), a3, voffA);
            PG8_WAIT_V(8); PG8_WAIT_L(0); PG8_BAR; PG8_MMA(1, 0, At, B0); PG8_MMA(1, 1, At, B1); PG8_BAR; PG8_SCHED;
            } else {
            PG8_LDB(B0, 0, 0); PG8_SCHED; PG8_LDA(At, 0, 0); PG8_STAGE(PG8_SA(1, 1), a1 + hstepA, voffA);
            PG8_WAIT_L(8); PG8_BAR; PG8_WAIT_L(0); PG8_MMA(0, 0, At, B0); PG8_BAR; PG8_SCHED;
            PG8_LDB(B1, 0, 1); PG8_STAGE(PG8_SB(0, 0), b2, voffB);
            PG8_BAR; PG8_WAIT_L(0); PG8_MMA(0, 1, At, B1); PG8_BAR;
            PG8_LDA(At, 0, 1); PG8_STAGE(PG8_SA(0, 0), a2, voffA);
            PG8_BAR; PG8_WAIT_L(0); PG8_MMA(1, 0, At, B0); PG8_BAR; PG8_SCHED;
            PG8_STAGE(PG8_SB(0, 1), b2 + hstepB, voffB);
            PG8_WAIT_V(6); PG8_BAR; PG8_MMA(1, 1, At, B1); PG8_BAR;
            PG8_LDB(B0, 1, 0); PG8_SCHED; PG8_LDA(At, 1, 0); PG8_STAGE(PG8_SA(0, 1), a2 + hstepA, voffA);
            PG8_WAIT_L(8); PG8_BAR; PG8_WAIT_L(0); PG8_MMA(0, 0, At, B0); PG8_BAR; PG8_SCHED;
            PG8_LDB(B1, 1, 1); PG8_STAGE(PG8_SB(1, 0), b3, voffB);
            PG8_BAR; PG8_WAIT_L(0); PG8_MMA(0, 1, At, B1); PG8_BAR;
            PG8_LDA(At, 1, 1); PG8_STAGE(PG8_SA(1, 0), a3, voffA);
            PG8_BAR; PG8_WAIT_L(0); PG8_MMA(1, 0, At, B0); PG8_BAR; PG8_SCHED;
            PG8_STAGE(PG8_SB(1, 1), b3 + hstepB, voffB);
            PG8_WAIT_V(6); PG8_BAR; PG8_MMA(1, 1, At, B1); PG8_BAR;
            }
        }
        if constexpr (ALIGN_EPI) { if (wr == 0) PG8_BAR; }
        if constexpr (!Epi::AFTER_DRAIN) { E(acc, cur, wr, wc, fr, fq); S.done(cur); }
        if (!has_next) break;
#pragma unroll
        for (int a = 0; a < 2; ++a)
#pragma unroll
            for (int b = 0; b < 2; ++b)
#pragma unroll
                for (int m = 0; m < 4; ++m)
#pragma unroll
                    for (int n = 0; n < 2; ++n) acc[a][b][m][n] = (f32x4){0.f, 0.f, 0.f, 0.f};
        cur = nxt; cA = nA; cB = nB; ++ui;
        if constexpr (ALIGN_EPI) { if (wr == 1) PG8_BAR; }
    }
    PG8_WAIT_V(0);
    if constexpr (!ALIGN_EPI) { if (wr == 0) PG8_BAR; }
    PG8_BAR;
    if constexpr (Epi::AFTER_DRAIN) { E.fused(acc, cur, wr, wc, fr, fq, lds, wid, lane); S.done(cur); }
#undef PG8_SA
#undef PG8_SB
#undef PG8_STAGE
#undef PG8_LDA
#undef PG8_LDB
#undef PG8_MMA
#undef PG8_WAIT_V
#undef PG8_WAIT_L
#undef PG8_BAR
#undef PG8_SCHED
}
}

constexpr int NWAVES = 8;
constexpr int BATCH = 4, SEQ = 4096, DM = 2048, FF = 5632, DEPTH = 4, M = BATCH * SEQ;
constexpr int NIN = 4928, NINP = 5120;
constexpr int MEML = 256, MMEM = BATCH * MEML;
constexpr int UC_Q1 = 0, UC_Q2 = 256, UC_K1 = 512, UC_K2 = 768, UC_VA = 1024, UC_CQ = 1536, UC_CKV = 2048, UC_KR = 2560, UC_QC = 2816, UC_KC = 3584, UC_VC = 4352;
constexpr int NUQ = 1152, NUQP = 1280, NUKV = 1536;
constexpr size_t WO_GU1 = 0;
constexpr size_t WO_D1  = WO_GU1 + (size_t)2 * FF * DM;
constexpr size_t WO_IN  = WO_D1 + (size_t)DM * FF;
constexpr size_t WO_UQ  = WO_IN + (size_t)NINP * DM;
constexpr size_t WO_UKV = WO_UQ + (size_t)NUQP * 512;
constexpr size_t WO_OUT = WO_UKV + (size_t)NUKV * 512;
constexpr size_t WO_CQ  = WO_OUT + (size_t)DM * DM;
constexpr size_t WO_CKV = WO_CQ + (size_t)512 * DM;
constexpr size_t WO_CO  = WO_CKV + (size_t)1024 * DM;
constexpr size_t WO_GU2 = WO_CO + (size_t)DM * 512;
constexpr size_t WO_D2  = WO_GU2 + (size_t)2 * FF * DM;
constexpr size_t W_LAYER = WO_D2 + (size_t)DM * FF;
constexpr size_t MiB = 1u << 20;
constexpr size_t WS_CTL = 0, CTL_ZERO_BYTES = 256 * 1024;
constexpr size_t WS_COS64 = 1 * MiB, WS_SIN64 = 3 * MiB, WS_COS128 = 5 * MiB, WS_SIN128 = 9 * MiB;
constexpr size_t WS_LAM = WS_CTL + 524288, WS_MSTAT = WS_CTL + 589824;
constexpr size_t WS_SQ = 13 * MiB, WS_SKV = WS_SQ + 524288, WS_STATS = 14 * MiB;
constexpr size_t WS_W = 16 * MiB;
constexpr size_t WS_XN = 700 * MiB;
constexpr size_t WS_MEMB = 764 * MiB;
constexpr size_t WS_BIG = 768 * MiB;
constexpr size_t WS_U = WS_BIG;
constexpr size_t WS_QM = WS_U + (size_t)M * NINP * 2;
constexpr size_t WS_KVM = WS_QM + (size_t)M * NUQP * 2;
constexpr size_t WS_Y = WS_KVM + (size_t)M * NUKV * 2;
constexpr size_t WS_A1 = WS_Y + (size_t)M * DM * 2;
constexpr size_t WS_OD = WS_A1 + (size_t)M * 512 * 4;
constexpr size_t WS_LSE = WS_OD + (size_t)3 * M * 768 * 2;
constexpr size_t WS_CQ2 = WS_LSE + (size_t)3 * M * 8 * 4;
constexpr size_t WS_OC = WS_CQ2 + (size_t)M * 512 * 2;
constexpr size_t WS_KVC = WS_OC + (size_t)M * 512 * 2;
constexpr size_t WS_HID = WS_KVC + (size_t)MMEM * 1024 * 2;
constexpr size_t WS_LO = WS_HID + (size_t)M * FF * 2;
constexpr size_t WS_END = WS_LO + (size_t)M * DM * 2;
constexpr size_t WS_GU = WS_U, WS_CQN = WS_U, WS_CKVN = WS_U, WS_MEMN = WS_U;
static_assert(WS_END <= (size_t)1490 * MiB, "workspace: sum of the inputs is 1495 MiB");
constexpr int CW_BAR = 4096, CW_LBAR = 8192, CW_Q = 16384, CW_PBAR = 24576;
static_assert((size_t)(CW_PBAR + 4 * 3456) * 4 <= CTL_ZERO_BYTES && CTL_ZERO_BYTES <= 524288, "every barrier / queue word inside the per-call memset, the prologue's tables outside it");
constexpr int RING_OFF = 0, RING_BYTES = 131072;
constexpr int LDSCTL_OFF = RING_BYTES, MISC_OFF = LDSCTL_OFF + 320, RSTD_OFF = LDSCTL_OFF + 1024;
constexpr int LDS_BYTES = 147456;

#ifndef FA_DIFF
#define FA_DIFF 1
#endif
#ifndef FA_MLA
#define FA_MLA 1
#endif
#ifndef FA_DIL
#define FA_DIL 1
#endif
#ifndef FA_CROSS
#define FA_CROSS 1
#endif
#define GAS __attribute__((address_space(1)))
#define LAS __attribute__((address_space(3)))
typedef unsigned short bf16;
typedef unsigned v4u __attribute__((ext_vector_type(4)));
typedef float f32x4 __attribute__((ext_vector_type(4)));
typedef GAS unsigned gu32;
#define RLX_AGENT __ATOMIC_RELAXED, __HIP_MEMORY_SCOPE_AGENT
#define LDS_WAIT() asm volatile("s_waitcnt lgkmcnt(0)" ::: "memory")
#define VM_WAIT() asm volatile("s_waitcnt vmcnt(0)" ::: "memory")
__device__ __forceinline__ unsigned pk2(float lo, float hi) { unsigned r; asm("v_cvt_pk_bf16_f32 %0, %1, %2" : "=v"(r) : "v"(lo), "v"(hi)); return r; }
__device__ __forceinline__ unsigned f2bf(float f) { return pk2(f, f) & 0xffffu; }
__device__ __forceinline__ float bflo(unsigned u) { return __builtin_bit_cast(float, u << 16); }
__device__ __forceinline__ float bfhi(unsigned u) { return __builtin_bit_cast(float, u & 0xffff0000u); }
__device__ __forceinline__ float bf1(bf16 h) { return __builtin_bit_cast(float, (unsigned)h << 16); }

#define XB_TMO      128
#define XB_XCNT(j)  (256  + 64 * (j))
#define XB_XSUB(j)  (1280 + 64 * (j))
#define XB_XGEN(j)  (2304 + 64 * (j))
#define XB_TOP      3328
#define XB_TOPGEN   3392
#define XCD_BAR_WORDS 3456
#define XB_SPIN_CAP (1u << 18)

__device__ __forceinline__ unsigned xb_ld(unsigned* p)              { return __hip_atomic_load(p, __ATOMIC_RELAXED, __HIP_MEMORY_SCOPE_AGENT); }
__device__ __forceinline__ unsigned xb_add(unsigned* p, unsigned v) { return __hip_atomic_fetch_add(p, v, __ATOMIC_RELAXED, __HIP_MEMORY_SCOPE_AGENT); }
__device__ __forceinline__ unsigned xb_xcc_id() { return (unsigned)__builtin_amdgcn_s_getreg((3 << 11) | 20) & 0xFu; }
#define XB_SPIN(cond, bar) do { unsigned _sp = 0; while (cond) { __builtin_amdgcn_s_sleep(1); \
    if ((++_sp & 255u) == 0u) { if (xb_ld(&(bar)[XB_TMO])) break; if (_sp > XB_SPIN_CAP) { atomicAdd(&(bar)[XB_TMO], 1u); break; } } } } while (0)

struct XcdBarrier {
    unsigned* bar; unsigned x;
    volatile LAS unsigned* st;
};

__device__ __forceinline__ XcdBarrier xcd_barrier_post(unsigned* bar, volatile LAS unsigned* st) {
    XcdBarrier b; b.bar = bar; b.x = xb_xcc_id(); b.st = st;
    if (threadIdx.x == 0) (void)xb_add(&bar[XB_XCNT(b.x)], 1u);
    return b;
}
__device__ __forceinline__ void xcd_barrier_complete(unsigned* bar, unsigned x, unsigned& nloc, unsigned& nx) {
    const unsigned G = gridDim.x * gridDim.y * gridDim.z;
    unsigned sum, cnt, mine, sp = 0u;
    for (;;) {
        sum = 0u; cnt = 0u; mine = 0u;
#pragma unroll
        for (unsigned j = 0; j < 16; ++j) { const unsigned c = xb_ld(&bar[XB_XCNT(j)]); sum += c; cnt += (c > 0u) ? 1u : 0u; mine = (j == x) ? c : mine; }
        if (sum == G) break;
        __builtin_amdgcn_s_sleep(1);
        if ((++sp & 255u) == 0u) { if (xb_ld(&bar[XB_TMO])) break; if (sp > XB_SPIN_CAP) { atomicAdd(&bar[XB_TMO], 1u); break; } }
    }
    nloc = mine > 0u ? mine : 1u; nx = cnt > 0u ? cnt : 1u;
}

__device__ __forceinline__ void xcd_barrier(const XcdBarrier& b, const bool leader  ) {
    asm volatile("s_waitcnt vmcnt(0)" ::: "memory");
    __syncthreads();
    if (leader) {
        unsigned* bar = b.bar;
        __builtin_amdgcn_s_waitcnt(0);
        unsigned nloc = b.st[0], nx = b.st[1];
        if (nloc == 0u) { xcd_barrier_complete(bar, b.x, nloc, nx); b.st[0] = nloc; b.st[1] = nx; }
        const unsigned old = xb_add(&bar[XB_XSUB(b.x)], 1u);
        const unsigned gen = old / nloc;
        if (old + 1u == (gen + 1u) * nloc) {
            __builtin_amdgcn_fence(__ATOMIC_RELEASE, "agent");
            asm volatile("s_waitcnt vmcnt(0)" ::: "memory");
            const unsigned og = xb_add(&bar[XB_TOP], 1u);
            const unsigned tg = og / nx;
            if (og + 1u == (tg + 1u) * nx) xb_add(&bar[XB_TOPGEN], 1u);
            else XB_SPIN(xb_ld(&bar[XB_TOPGEN]) == tg, bar);
            __builtin_amdgcn_fence(__ATOMIC_ACQUIRE, "agent");
            xb_add(&bar[XB_XGEN(b.x)], 1u);
            asm volatile("s_waitcnt vmcnt(0)" ::: "memory");
        } else {
            XB_SPIN(xb_ld(&bar[XB_XGEN(b.x)]) == gen, bar);
            __builtin_amdgcn_fence(__ATOMIC_ACQUIRE, "agent");
            asm volatile("s_waitcnt vmcnt(0)" ::: "memory");
        }
    }
    __syncthreads();
}

struct Params {
    const float* in[26]; float* out; unsigned char* ws;
    float inv64[32]; float inv128[64]; float lam_init[4];
    int ph_lo, ph_hi, use_bar, pad;
};
enum InIdx { I_X = 0, I_MEM, I_POS, I_F1N, I_F1G, I_F1U, I_F1D, I_MIXN, I_WIN, I_DLAM, I_DSUB, I_QN, I_WUQ, I_KVN, I_WUKV, I_WOUT, I_CRN, I_MEMN, I_CWQ, I_CWKV, I_CWO, I_F2N, I_F2G, I_F2U, I_F2D, I_FINN };

__device__ __forceinline__ int fresh_lane() { int l; asm volatile("v_mbcnt_lo_u32_b32 %0, -1, 0\n\tv_mbcnt_hi_u32_b32 %0, -1, %0" : "=v"(l)); return l; }
__device__ __forceinline__ float lane_xor(float v, int lane, int o) { return __builtin_bit_cast(float, __builtin_amdgcn_ds_bpermute((lane ^ o) << 2, __builtin_bit_cast(int, v))); }
__device__ __forceinline__ float wave_sum(float v, int lane) {
#pragma unroll
    for (int o = 1; o < 64; o <<= 1) v += lane_xor(v, lane, o);
    return v;
}
__device__ __forceinline__ void transpose_item(const float* W, int K, int N, bf16* WT, int row_off, int split, int pad, LAS float* scr, int item, int lane) {
    const int nblk = N / 32, kb = item / nblk, nb = item % nblk, k0 = 64 * kb, n0 = 32 * nb;
#pragma unroll 8
    for (int i = 0; i < 32; ++i) { const int kk = 2 * i + (lane >> 5); scr[kk * 33 + (lane & 31)] = W[(size_t)(k0 + kk) * N + n0 + (lane & 31)]; }
    LDS_WAIT(); asm volatile("" ::: "memory");
    const int c = lane & 7;
#pragma unroll
    for (int j = 0; j < 4; ++j) { const int n = (lane >> 3) + 8 * j; const LAS float* s = scr + (8 * c) * 33 + n;
        v4u o; o.x = pk2(s[0 * 33], s[1 * 33]); o.y = pk2(s[2 * 33], s[3 * 33]); o.z = pk2(s[4 * 33], s[5 * 33]); o.w = pk2(s[6 * 33], s[7 * 33]);
        const int nn = n0 + n, dr = row_off + nn + (nn >= split ? pad : 0);
        *(GAS v4u*)(WT + (size_t)dr * K + k0 + 8 * c) = o; }
    LDS_WAIT(); asm volatile("" ::: "memory");
}
#define CONV(Wp, K_, N_, WTp, roff, split, pad) do { const int nit_ = ((K_) / 64) * ((N_) / 32); for (int it_ = gw; it_ < nit_; it_ += NGW) transpose_item((Wp), (K_), (N_), (WTp), (roff), (split), (pad), scr, it_, lane); } while (0)

__device__ __forceinline__ void sincos_rad(float ang, float& c, float& s) {
    double r = (double)ang * 0.15915494309189533577; r -= __builtin_floor(r); const float rf = (float)r;
    c = __builtin_amdgcn_cosf(rf); s = __builtin_amdgcn_sinf(rf);
}

__device__ __forceinline__ void nv_norm_rows(const float* src, const float* g, bf16* dst, int nrows, int gw, int NGW, int lane) {
    for (int m = gw; m < nrows; m += NGW) {
        const f32x4* xr = (const f32x4*)(src + (size_t)m * DM) + lane; const f32x4* gr = (const f32x4*)g + lane;
        f32x4 v[8]; float s = 0.f;
#pragma unroll
        for (int j = 0; j < 8; ++j) { v[j] = xr[64 * j]; s += (v[j].x * v[j].x + v[j].y * v[j].y) + (v[j].z * v[j].z + v[j].w * v[j].w); }
        const float rstd = 1.0f / sqrtf(wave_sum(s, lane) * (1.0f / DM) + 1e-6f);
        unsigned long long* o8 = (unsigned long long*)(dst + (size_t)m * DM) + lane;
#pragma unroll
        for (int j = 0; j < 8; ++j) { const f32x4 gg = gr[64 * j];
            o8[64 * j] = (unsigned long long)pk2(v[j].x * rstd * gg.x, v[j].y * rstd * gg.y) | ((unsigned long long)pk2(v[j].z * rstd * gg.z, v[j].w * rstd * gg.w) << 32); }
    }
}
__device__ __forceinline__ void nv_final_norm(float* h, const float* g, int gw, int NGW, int lane) {
    for (int m = gw; m < M; m += NGW) {
        f32x4* xr = (f32x4*)(h + (size_t)m * DM) + lane; const f32x4* gr = (const f32x4*)g + lane;
        f32x4 v[8]; float s = 0.f;
#pragma unroll
        for (int j = 0; j < 8; ++j) { v[j] = xr[64 * j]; s += (v[j].x * v[j].x + v[j].y * v[j].y) + (v[j].z * v[j].z + v[j].w * v[j].w); }
        const float rstd = 1.0f / sqrtf(wave_sum(s, lane) * (1.0f / DM) + 1e-6f);
#pragma unroll
        for (int j = 0; j < 8; ++j) { const f32x4 gg = gr[64 * j]; xr[64 * j] = (v[j] * rstd) * gg; }
    }
}
__device__ __forceinline__ void nv_swiglu(const bf16* GU, bf16* HID, int gtid, int gsize) {
    constexpr int C8 = FF / 8;
    for (int it = gtid; it < M * C8; it += gsize) { const int m = it / C8, j = (it % C8) * 8;
        const v4u g = *(const v4u*)(GU + (size_t)m * 2 * FF + j), u = *(const v4u*)(GU + (size_t)m * 2 * FF + FF + j);
        float gv[8] = {bflo(g.x), bfhi(g.x), bflo(g.y), bfhi(g.y), bflo(g.z), bfhi(g.z), bflo(g.w), bfhi(g.w)};
        float uv[8] = {bflo(u.x), bfhi(u.x), bflo(u.y), bfhi(u.y), bflo(u.z), bfhi(u.z), bflo(u.w), bfhi(u.w)};
        float r[8];
#pragma unroll
        for (int i = 0; i < 8; ++i) r[i] = gv[i] / (1.0f + __expf(-gv[i])) * uv[i];
        v4u o; o.x = pk2(r[0], r[1]); o.y = pk2(r[2], r[3]); o.z = pk2(r[4], r[5]); o.w = pk2(r[6], r[7]);
        *(v4u*)(HID + (size_t)m * FF + j) = o; }
}
__device__ __forceinline__ void nv_mix_post(bf16* U, const float* cos64, const float* sin64, const float* cos128, const float* sin128, const float* gq, const float* gkv, bf16* CQN, bf16* CKVN, int gw, int NGW, int lane) {
    for (int m = gw; m < M; m += NGW) {
        bf16* ur = U + (size_t)m * NINP;
        for (int p = lane; p < 1312; p += 64) {
            int c1, half; float cs, sn;
            if (p < 512) { const int i = p & 31; c1 = (p >> 5) * 64 + i; half = 32; cs = cos64[m * 32 + i]; sn = sin64[m * 32 + i]; }
            else if (p < 544) { const int i = p - 512; c1 = UC_KR + i; half = 32; cs = cos64[m * 32 + i]; sn = sin64[m * 32 + i]; }
            else { const int q = p - 544, i = q & 63; c1 = UC_QC + (q >> 6) * 128 + i; half = 64; cs = cos128[m * 64 + i]; sn = sin128[m * 64 + i]; }
            const float x1 = bf1(ur[c1]), x2 = bf1(ur[c1 + half]);
            ur[c1] = (bf16)f2bf(x1 * cs - x2 * sn); ur[c1 + half] = (bf16)f2bf(x1 * sn + x2 * cs);
        }
#pragma unroll
        for (int w = 0; w < 2; ++w) {
            const v4u x = *(const v4u*)(ur + (w ? UC_CKV : UC_CQ) + 8 * lane); const float* g = (w ? gkv : gq) + 8 * lane;
            float v[8] = {bflo(x.x), bfhi(x.x), bflo(x.y), bfhi(x.y), bflo(x.z), bfhi(x.z), bflo(x.w), bfhi(x.w)}; float s = 0.f;
#pragma unroll
            for (int i = 0; i < 8; ++i) s += v[i] * v[i];
            const float rstd = 1.0f / sqrtf(wave_sum(s, lane) * (1.0f / 512.0f) + 1e-6f);
            v4u o; o.x = pk2(v[0] * rstd * g[0], v[1] * rstd * g[1]); o.y = pk2(v[2] * rstd * g[2], v[3] * rstd * g[3]); o.z = pk2(v[4] * rstd * g[4], v[5] * rstd * g[5]); o.w = pk2(v[6] * rstd * g[6], v[7] * rstd * g[7]);
            *(v4u*)((w ? CKVN : CQN) + (size_t)m * 512 + 8 * lane) = o;
        }
    }
}
__device__ __forceinline__ void nv_mla_post(bf16* QM, const float* cos64, const float* sin64, int gw, int NGW, int lane) {
    for (int m = gw; m < M; m += NGW) {
        bf16* qr = QM + (size_t)m * NUQP;
        for (int p = lane; p < 192; p += 64) { const int i = p & 31, c1 = (p >> 5) * 192 + 128 + i; const float cs = cos64[m * 32 + i], sn = sin64[m * 32 + i];
            const float x1 = bf1(qr[c1]), x2 = bf1(qr[c1 + 32]); qr[c1] = (bf16)f2bf(x1 * cs - x2 * sn); qr[c1 + 32] = (bf16)f2bf(x1 * sn + x2 * cs); }
    }
}
struct NvState { float m, l; float o[32]; };
__device__ __forceinline__ void nv_init(NvState& st) { st.m = -INFINITY; st.l = 0.f;
#pragma unroll
    for (int d = 0; d < 32; ++d) st.o[d] = 0.f; }
template <int NP> __device__ __forceinline__ void nv_loadq(unsigned (&q)[NP], const bf16* p) {
#pragma unroll
    for (int i = 0; i < NP / 4; ++i) { const v4u x = *(const v4u*)(p + 8 * i); q[4 * i] = x.x; q[4 * i + 1] = x.y; q[4 * i + 2] = x.z; q[4 * i + 3] = x.w; } }
template <int NP> __device__ __forceinline__ float nv_dot(const unsigned (&q)[NP], const bf16* k) {
    float s = 0.f;
#pragma unroll
    for (int i = 0; i < NP / 4; ++i) { const v4u x = *(const v4u*)(k + 8 * i);
        s += bflo(q[4 * i]) * bflo(x.x) + bfhi(q[4 * i]) * bfhi(x.x) + bflo(q[4 * i + 1]) * bflo(x.y) + bfhi(q[4 * i + 1]) * bfhi(x.y)
           + bflo(q[4 * i + 2]) * bflo(x.z) + bfhi(q[4 * i + 2]) * bfhi(x.z) + bflo(q[4 * i + 3]) * bflo(x.w) + bfhi(q[4 * i + 3]) * bfhi(x.w); }
    return s; }
__device__ __forceinline__ float quad_sum(float v, int lane) { v += lane_xor(v, lane, 1); v += lane_xor(v, lane, 2); return v; }
__device__ __forceinline__ void nv_upd(NvState& st, float s, const bf16* v) {
    const float mn = fmaxf(st.m, s), a = __expf(st.m - mn), p = __expf(s - mn); st.m = mn; st.l = st.l * a + p;
#pragma unroll
    for (int i = 0; i < 4; ++i) { const v4u x = *(const v4u*)(v + 8 * i);
        st.o[8 * i + 0] = st.o[8 * i + 0] * a + p * bflo(x.x); st.o[8 * i + 1] = st.o[8 * i + 1] * a + p * bfhi(x.x); st.o[8 * i + 2] = st.o[8 * i + 2] * a + p * bflo(x.y); st.o[8 * i + 3] = st.o[8 * i + 3] * a + p * bfhi(x.y);
        st.o[8 * i + 4] = st.o[8 * i + 4] * a + p * bflo(x.z); st.o[8 * i + 5] = st.o[8 * i + 5] * a + p * bfhi(x.z); st.o[8 * i + 6] = st.o[8 * i + 6] * a + p * bflo(x.w); st.o[8 * i + 7] = st.o[8 * i + 7] * a + p * bfhi(x.w); }
}
__device__ __forceinline__ void nv_store(bf16* dst, const float (&o)[32], float sc) {
#pragma unroll
    for (int i = 0; i < 4; ++i) { v4u w; w.x = pk2(o[8 * i] * sc, o[8 * i + 1] * sc); w.y = pk2(o[8 * i + 2] * sc, o[8 * i + 3] * sc); w.z = pk2(o[8 * i + 4] * sc, o[8 * i + 5] * sc); w.w = pk2(o[8 * i + 6] * sc, o[8 * i + 7] * sc);
        *(v4u*)(dst + 8 * i) = w; } }
__device__ __forceinline__ void nv_attn_diff(const bf16* U, bf16* Y, const float* subln, float lam, float lam_init, int gtid, int gsize, int lane) {
    for (int task = gtid; task < M * 4 * 4; task += gsize) {
        const int qt = task & 3, idx = task >> 2, h = idx / M, m = idx % M, b = m / SEQ, s = m % SEQ;
        const bf16* qrow = U + (size_t)m * NINP; unsigned q1[8], q2[8];
        nv_loadq<8>(q1, qrow + UC_Q1 + h * 64 + qt * 16); nv_loadq<8>(q2, qrow + UC_Q2 + h * 64 + qt * 16);
        NvState a1, a2; nv_init(a1); nv_init(a2);
        const bf16* kb = U + (size_t)(b * SEQ) * NINP;
        for (int j = 0; j <= s; ++j) { const bf16* kr = kb + (size_t)j * NINP;
            const float s1 = quad_sum(nv_dot<8>(q1, kr + UC_K1 + h * 64 + qt * 16), lane) * 0.125f, s2 = quad_sum(nv_dot<8>(q2, kr + UC_K2 + h * 64 + qt * 16), lane) * 0.125f;
            const bf16* v = kr + UC_VA + h * 128 + qt * 32; nv_upd(a1, s1, v); nv_upd(a2, s2, v); }
        const float i1 = 1.0f / a1.l, i2 = lam / a2.l; float ss = 0.f;
#pragma unroll
        for (int d = 0; d < 32; ++d) { a1.o[d] = a1.o[d] * i1 - a2.o[d] * i2; ss += a1.o[d] * a1.o[d]; }
        ss = quad_sum(ss, lane);
        const float rstd = (1.0f / sqrtf(ss * (1.0f / 128.0f) + 1e-5f)) * (1.0f - lam_init);
#pragma unroll
        for (int d = 0; d < 32; ++d) a1.o[d] *= subln[qt * 32 + d];
        nv_store(Y + (size_t)m * DM + h * 128 + qt * 32, a1.o, rstd);
    }
}
__device__ __forceinline__ void nv_attn_mla(const bf16* QM, int qn0, int qns, int qr0, int qrs, const bf16* KVM, const bf16* U, bf16* Y, int gtid, int gsize, int lane) {
    for (int task = gtid; task < M * 6 * 4; task += gsize) {
        const int qt = task & 3, idx = task >> 2, h = idx / M, m = idx % M, b = m / SEQ, s = m % SEQ;
        unsigned qn[16], qr[8]; nv_loadq<16>(qn, QM + (size_t)m * NUQP + qn0 + h * qns + qt * 32); nv_loadq<8>(qr, QM + (size_t)m * NUQP + qr0 + h * qrs + qt * 16);
        NvState a; nv_init(a);
        for (int j = 0; j <= s; ++j) { const size_t kr = (size_t)(b * SEQ + j);
            const float sc = quad_sum(nv_dot<16>(qn, KVM + kr * NUKV + h * 256 + qt * 32) + nv_dot<8>(qr, U + kr * NINP + UC_KR + qt * 16), lane) * 0.07216878364870322f;
            nv_upd(a, sc, KVM + kr * NUKV + h * 256 + 128 + qt * 32); }
        nv_store(Y + (size_t)m * DM + 512 + h * 128 + qt * 32, a.o, 1.0f / a.l);
    }
}
__device__ __forceinline__ void nv_attn_dil(const bf16* U, bf16* Y, int gtid, int gsize, int lane) {
    for (int task = gtid; task < M * 6 * 4; task += gsize) {
        const int qt = task & 3, idx = task >> 2, h = idx / M, m = idx % M, b = m / SEQ, s = m % SEQ;
        unsigned q[16]; nv_loadq<16>(q, U + (size_t)m * NINP + UC_QC + h * 128 + qt * 32);
        NvState a; nv_init(a);
        for (int p = 0; p < 3; ++p) { const int dil = (p == 0) ? 1 : (p == 1) ? 4 : 16;
            for (int j = 0; j <= 128; ++j) { const int kj = s - j * dil; if (kj < 0) break;
                const bf16* kr = U + (size_t)(b * SEQ + kj) * NINP;
                const float sc = quad_sum(nv_dot<16>(q, kr + UC_KC + h * 128 + qt * 32), lane) * 0.08838834764831845f;
                nv_upd(a, sc, kr + UC_VC + h * 128 + qt * 32); } }
        nv_store(Y + (size_t)m * DM + 1280 + h * 128 + qt * 32, a.o, 1.0f / a.l);
    }
}
__device__ __forceinline__ void nv_attn_cross(const bf16* CQ2, const bf16* KVC, bf16* OC, int gtid, int gsize, int lane) {
    for (int task = gtid; task < M * 4 * 4; task += gsize) {
        const int qt = task & 3, idx = task >> 2, h = idx / M, m = idx % M, b = m / SEQ;
        unsigned q[16]; nv_loadq<16>(q, CQ2 + (size_t)m * 512 + h * 128 + qt * 32);
        NvState a; nv_init(a);
        for (int j = 0; j < MEML; ++j) { const bf16* kr = KVC + (size_t)(b * MEML + j) * 1024;
            const float sc = quad_sum(nv_dot<16>(q, kr + h * 128 + qt * 32), lane) * 0.08838834764831845f;
            nv_upd(a, sc, kr + 512 + h * 128 + qt * 32); }
        nv_store(OC + (size_t)m * 512 + h * 128 + qt * 32, a.o, 1.0f / a.l);
    }
}

#ifndef PVP64
#define PVP64 1
#endif
#ifndef PVP128M
#define PVP128M 0
#endif
#ifndef PVP128U
#define PVP128U 1
#endif
#ifndef PVPIPE_SB
#define PVPIPE_SB 1
#endif
#define PVPIPE_BODY(DK, MASKED) ((DK) == 64 ? (PVP64 != 0) : (MASKED) ? (PVP128M != 0) : (PVP128U != 0))
#ifndef PVX
#define PVX 1
#endif
#ifndef DMA_DIFF
#define DMA_DIFF 1
#endif
#ifndef DMA_DIL
#define DMA_DIL 1
#endif
#ifndef DMA_CROSS
#define DMA_CROSS 1
#endif
namespace fa {
typedef short bf16x8 __attribute__((ext_vector_type(8)));
typedef short s16x4 __attribute__((ext_vector_type(4)));
typedef float f32x16 __attribute__((ext_vector_type(16)));
typedef unsigned u32x4 __attribute__((ext_vector_type(4)));
constexpr int KVBLK = 64, QBLK = 32;
constexpr int SHM_V = KVBLK * 128 * 2;
#define FA_SBAR() __builtin_amdgcn_sched_barrier(0)
__device__ __forceinline__ int crow(int r, int hi) { return (r & 3) + 8 * (r >> 2) + 4 * hi; }
__device__ __forceinline__ unsigned cvtpk(float lo, float hi) { unsigned r; asm volatile("v_cvt_pk_bf16_f32 %0, %1, %2" : "=v"(r) : "v"(lo), "v"(hi)); return r; }
struct Desc {
    const bf16* q0; const bf16* q1; int qstride;
    const bf16* k0; int k0stride; const bf16* k1; int k1stride;
    const bf16* v; int vstride;
    int t0, t1;
    int qpos0, band;
};
__device__ __forceinline__ void partialSM(f32x16& p0, f32x16& p1, float& m_reg, float& mn, float& alpha, const float C, const float thrs) {
    float pmax = p0[0];
#pragma unroll
    for (int r = 1; r < 16; ++r) pmax = fmaxf(pmax, p0[r]);
#pragma unroll
    for (int r = 0; r < 16; ++r) pmax = fmaxf(pmax, p1[r]);
    { auto rr = __builtin_amdgcn_permlane32_swap(__float_as_uint(pmax), __float_as_uint(pmax), false, false); pmax = fmaxf(__uint_as_float(rr[0]), __uint_as_float(rr[1])); }
    if (__builtin_expect(__all(pmax - m_reg <= thrs), 1)) { mn = m_reg; alpha = 1.f; }
    else { mn = fmaxf(m_reg, pmax); alpha = __builtin_amdgcn_exp2f((m_reg - mn) * C); m_reg = mn; }
    const float mnC = -mn * C;
#pragma unroll
    for (int r = 0; r < 16; ++r) p0[r] = fmaf(p0[r], C, mnC);
#pragma unroll
    for (int r = 0; r < 16; ++r) p1[r] = fmaf(p1[r], C, mnC);
#pragma unroll
    for (int r = 0; r < 16; ++r) p0[r] = __builtin_amdgcn_exp2f(p0[r]);
}
__device__ __forceinline__ void finishSM(f32x16& p0, f32x16& p1, float alpha, float& l_reg, bf16x8& pa0, bf16x8& pa1, bf16x8& pa2, bf16x8& pa3) {
#pragma unroll
    for (int r = 0; r < 16; ++r) p1[r] = __builtin_amdgcn_exp2f(p1[r]);
    float ps = 0;
#pragma unroll
    for (int r = 0; r < 16; ++r) ps += p0[r];
#pragma unroll
    for (int r = 0; r < 16; ++r) ps += p1[r];
    { auto rr = __builtin_amdgcn_permlane32_swap(__float_as_uint(ps), __float_as_uint(ps), false, false); ps = __uint_as_float(rr[0]) + __uint_as_float(rr[1]); }
    l_reg = l_reg * alpha + ps;
#define FA_PK4(P, BASE, OUT) do { unsigned a0 = cvtpk(P[BASE + 0], P[BASE + 1]), a1 = cvtpk(P[BASE + 2], P[BASE + 3]);   \
    unsigned b0 = cvtpk(P[BASE + 4], P[BASE + 5]), b1 = cvtpk(P[BASE + 6], P[BASE + 7]);                              \
    auto r0 = __builtin_amdgcn_permlane32_swap(a0, b0, false, false); auto r1 = __builtin_amdgcn_permlane32_swap(a1, b1, false, false); \
    u32x4 w = {r0[0], r1[0], r0[1], r1[1]}; OUT = __builtin_bit_cast(bf16x8, w); } while (0)
    FA_PK4(p0, 0, pa0); FA_PK4(p0, 8, pa1); FA_PK4(p1, 0, pa2); FA_PK4(p1, 8, pa3);
#undef FA_PK4
}
template <int DK> __device__ __forceinline__ int kswz(int row, int colB) { return row * (DK * 2) + (colB ^ ((row & 7) << 4)); }
template <int DK> __device__ __forceinline__ void qkt(f32x16& p0, f32x16& p1, const char* Ks, const bf16x8* qr, int r32, int hi) {
    p0 = f32x16{}; p1 = f32x16{};
#pragma unroll
    for (int d0 = 0; d0 < DK / 16; ++d0) { const int cb = (d0 * 16 + hi * 8) * 2;
        const bf16x8 b0 = *reinterpret_cast<const bf16x8*>(Ks + kswz<DK>(r32, cb));
        const bf16x8 b1 = *reinterpret_cast<const bf16x8*>(Ks + kswz<DK>(32 + r32, cb));
        p0 = __builtin_amdgcn_mfma_f32_32x32x16_bf16(b0, qr[d0], p0, 0, 0, 0);
        p1 = __builtin_amdgcn_mfma_f32_32x32x16_bf16(b1, qr[d0], p1, 0, 0, 0); }
}
template <int DK> __device__ __forceinline__ void qkt_c(f32x16& p0, f32x16& p1, const char* Ks, const bf16x8* qr, const f32x16& negm, int r32, int hi) {
#pragma unroll
    for (int d0 = 0; d0 < DK / 16; ++d0) { const int cb = (d0 * 16 + hi * 8) * 2;
        const bf16x8 b0 = *reinterpret_cast<const bf16x8*>(Ks + kswz<DK>(r32, cb));
        const bf16x8 b1 = *reinterpret_cast<const bf16x8*>(Ks + kswz<DK>(32 + r32, cb));
        if (d0 == 0) { p0 = __builtin_amdgcn_mfma_f32_32x32x16_bf16(b0, qr[0], negm, 0, 0, 0); p1 = __builtin_amdgcn_mfma_f32_32x32x16_bf16(b1, qr[0], negm, 0, 0, 0); }
        else { p0 = __builtin_amdgcn_mfma_f32_32x32x16_bf16(b0, qr[d0], p0, 0, 0, 0); p1 = __builtin_amdgcn_mfma_f32_32x32x16_bf16(b1, qr[d0], p1, 0, 0, 0); } }
}
template <bool FIRST, bool SAFE = false> __device__ __forceinline__ void partialSM_pre(f32x16& p0, f32x16& p1, float& mref, f32x16& negm, float& alpha, const float thrl, const float l_now = 1.f) {
    float pmax = p0[0];
#pragma unroll
    for (int r = 1; r < 16; ++r) pmax = fmaxf(pmax, p0[r]);
#pragma unroll
    for (int r = 0; r < 16; ++r) pmax = fmaxf(pmax, p1[r]);
    { auto rr = __builtin_amdgcn_permlane32_swap(__float_as_uint(pmax), __float_as_uint(pmax), false, false); pmax = fmaxf(__uint_as_float(rr[0]), __uint_as_float(rr[1])); }
    alpha = 1.f;
    const bool fresh = SAFE && !FIRST && (l_now == 0.f), seen = !SAFE || (pmax > -INFINITY);
    if (FIRST || !__builtin_expect(__all((pmax <= thrl) && !(fresh && seen)), 1)) {
        const float dl = (FIRST || fresh) ? (seen ? pmax : 0.f) : fmaxf(pmax, 0.f);
        mref = FIRST ? dl : mref + dl;
#pragma unroll
        for (int r = 0; r < 16; ++r) { p0[r] -= dl; p1[r] -= dl; }
#pragma unroll
        for (int r = 0; r < 16; ++r) negm[r] = -mref;
        asm volatile("" : "+v"(negm));
        if (!FIRST && !fresh) alpha = __builtin_amdgcn_exp2f(-dl);
    }
#pragma unroll
    for (int r = 0; r < 16; ++r) p0[r] = __builtin_amdgcn_exp2f(p0[r]);
}
__device__ __forceinline__ void band_mask(f32x16& p0, f32x16& p1, int qp, int tk, int hi, int band, int wq0) {
    if (wq0 - (tk + 63) >= 0 && (wq0 + 31) - tk <= band) return;
    const int d0 = qp - tk - 4 * hi;
#pragma unroll
    for (int r = 0; r < 16; ++r) { const int d = d0 - ((r & 3) + 8 * (r >> 2));
        if ((unsigned)d > (unsigned)band) p0[r] = -INFINITY;
        if ((unsigned)(d - 32) > (unsigned)band) p1[r] = -INFINITY; }
}
__device__ __forceinline__ int v_st(int k, int c) { const int kk = (k & ~0xC) | ((k & 4) << 1) | ((k & 8) >> 1); return ((kk >> 3) * 4 + (c >> 5)) * 512 + ((kk & 7) * 32 + (c & 31)) * 2; }
__device__ __forceinline__ int v_rd_base(int lane) { return ((lane & 3) << 3) | (((lane >> 2) & 3) << 6) | (((lane >> 4) & 1) << 5) | (((lane >> 5) & 1) << 8); }
constexpr int v_rd_off(int d0, int ks, int half) { return d0 * 512 + ks * 4096 + half * 2048; }
template <int OFF> __device__ __forceinline__ s16x4 tr_read(int vb) { s16x4 r; asm volatile("ds_read_b64_tr_b16 %0, %1 offset:%2" : "=&v"(r) : "v"(vb), "i"(OFF) : "memory"); return r; }
struct VFrag { s16x4 l0, h0, l1, h1, l2, h2, l3, h3; };
template <int D0> __device__ __forceinline__ void pv_rd(VFrag& f, int vb) {
    f.l0 = tr_read<v_rd_off(D0, 0, 0)>(vb); f.h0 = tr_read<v_rd_off(D0, 0, 1)>(vb); f.l1 = tr_read<v_rd_off(D0, 1, 0)>(vb); f.h1 = tr_read<v_rd_off(D0, 1, 1)>(vb);
    f.l2 = tr_read<v_rd_off(D0, 2, 0)>(vb); f.h2 = tr_read<v_rd_off(D0, 2, 1)>(vb); f.l3 = tr_read<v_rd_off(D0, 3, 0)>(vb); f.h3 = tr_read<v_rd_off(D0, 3, 1)>(vb);
}
__device__ __forceinline__ void pv_mm(f32x16& od, const VFrag& f, bf16x8 pa0, bf16x8 pa1, bf16x8 pa2, bf16x8 pa3) {
#define FA_PK(L, H) (bf16x8){L[0], L[1], L[2], L[3], H[0], H[1], H[2], H[3]}
    od = __builtin_amdgcn_mfma_f32_32x32x16_bf16(pa0, FA_PK(f.l0, f.h0), od, 0, 0, 0);
    od = __builtin_amdgcn_mfma_f32_32x32x16_bf16(pa1, FA_PK(f.l1, f.h1), od, 0, 0, 0);
    od = __builtin_amdgcn_mfma_f32_32x32x16_bf16(pa2, FA_PK(f.l2, f.h2), od, 0, 0, 0);
    od = __builtin_amdgcn_mfma_f32_32x32x16_bf16(pa3, FA_PK(f.l3, f.h3), od, 0, 0, 0);
#undef FA_PK
}
template <bool PIPE> __device__ __forceinline__ void pv_d0(f32x16* o, int vb, bf16x8 pa0, bf16x8 pa1, bf16x8 pa2, bf16x8 pa3) {
    if constexpr (!PIPE) {
        VFrag f_;
        pv_rd<0>(f_, vb); asm volatile("s_waitcnt lgkmcnt(0)" ::: "memory"); FA_SBAR(); pv_mm(o[0], f_, pa0, pa1, pa2, pa3);
        pv_rd<1>(f_, vb); asm volatile("s_waitcnt lgkmcnt(0)" ::: "memory"); FA_SBAR(); pv_mm(o[1], f_, pa0, pa1, pa2, pa3);
        pv_rd<2>(f_, vb); asm volatile("s_waitcnt lgkmcnt(0)" ::: "memory"); FA_SBAR(); pv_mm(o[2], f_, pa0, pa1, pa2, pa3);
        pv_rd<3>(f_, vb); asm volatile("s_waitcnt lgkmcnt(0)" ::: "memory"); FA_SBAR(); pv_mm(o[3], f_, pa0, pa1, pa2, pa3);
        return;
    }
    VFrag fa_, fb_;
    FA_SBAR(); pv_rd<0>(fa_, vb); pv_rd<1>(fb_, vb);
    asm volatile("s_waitcnt lgkmcnt(8)" ::: "memory"); FA_SBAR(); pv_mm(o[0], fa_, pa0, pa1, pa2, pa3); FA_SBAR();
    pv_rd<2>(fa_, vb);
    asm volatile("s_waitcnt lgkmcnt(8)" ::: "memory"); FA_SBAR(); pv_mm(o[1], fb_, pa0, pa1, pa2, pa3); FA_SBAR();
    pv_rd<3>(fb_, vb);
    asm volatile("s_waitcnt lgkmcnt(8)" ::: "memory"); FA_SBAR(); pv_mm(o[2], fa_, pa0, pa1, pa2, pa3); FA_SBAR();
    asm volatile("s_waitcnt lgkmcnt(0)" ::: "memory"); FA_SBAR(); pv_mm(o[3], fb_, pa0, pa1, pa2, pa3); FA_SBAR();
}
template <bool SAFE, bool DOMASK = false> __device__ __forceinline__ void pv_psm(f32x16* o, int vb, bf16x8 pa0, bf16x8 pa1, bf16x8 pa2, bf16x8 pa3, f32x16& p0, f32x16& p1, float& mref, f32x16& negm, float& alpha, const float thrl, const float l_now,
                                                                                       const int md0 = 0, const int band = 0) {
    VFrag fa_, fb_; float pmax;
    FA_SBAR(); pv_rd<0>(fa_, vb); pv_rd<1>(fb_, vb);
    asm volatile("s_waitcnt lgkmcnt(8)" ::: "memory"); FA_SBAR();
    pv_mm(o[0], fa_, pa0, pa1, pa2, pa3);
    if constexpr (DOMASK) {
#pragma unroll
        for (int r = 0; r < 16; ++r) { const int d = md0 - ((r & 3) + 8 * (r >> 2)); if ((unsigned)d > (unsigned)band) p0[r] = -INFINITY; } }
    pmax = p0[0];
#pragma unroll
    for (int r = 1; r < 16; ++r) pmax = fmaxf(pmax, p0[r]);
    FA_SBAR();
    pv_rd<2>(fa_, vb);
    asm volatile("s_waitcnt lgkmcnt(8)" ::: "memory"); FA_SBAR();
    pv_mm(o[1], fb_, pa0, pa1, pa2, pa3);
    if constexpr (DOMASK) {
#pragma unroll
        for (int r = 0; r < 16; ++r) { const int d = md0 - 32 - ((r & 3) + 8 * (r >> 2)); if ((unsigned)d > (unsigned)band) p1[r] = -INFINITY; } }
#pragma unroll
    for (int r = 0; r < 16; ++r) pmax = fmaxf(pmax, p1[r]);
    { auto rr = __builtin_amdgcn_permlane32_swap(__float_as_uint(pmax), __float_as_uint(pmax), false, false); pmax = fmaxf(__uint_as_float(rr[0]), __uint_as_float(rr[1])); }
    FA_SBAR();
    pv_rd<3>(fb_, vb);
    alpha = 1.f;
    { const bool fresh = SAFE && (l_now == 0.f), seen = !SAFE || (pmax > -INFINITY);
      if (!__builtin_expect(__all((pmax <= thrl) && !(fresh && seen)), 1)) {
        const float dl = fresh ? (seen ? pmax : 0.f) : fmaxf(pmax, 0.f);
        mref = mref + dl;
#pragma unroll
        for (int r = 0; r < 16; ++r) { p0[r] -= dl; p1[r] -= dl; }
#pragma unroll
        for (int r = 0; r < 16; ++r) negm[r] = -mref;
        asm volatile("" : "+v"(negm));
        if (!fresh) alpha = __builtin_amdgcn_exp2f(-dl);
      } }
    asm volatile("s_waitcnt lgkmcnt(8)" ::: "memory"); FA_SBAR();
    pv_mm(o[2], fa_, pa0, pa1, pa2, pa3);
#pragma unroll
    for (int r = 0; r < 8; ++r) p0[r] = __builtin_amdgcn_exp2f(p0[r]);
    asm volatile("" : "+v"(p0));
    FA_SBAR();
    asm volatile("s_waitcnt lgkmcnt(0)" ::: "memory"); FA_SBAR();
    pv_mm(o[3], fb_, pa0, pa1, pa2, pa3);
#pragma unroll
    for (int r = 8; r < 16; ++r) p0[r] = __builtin_amdgcn_exp2f(p0[r]);
    asm volatile("" : "+v"(p0));
    FA_SBAR();
}
constexpr int NBUF = 3;
template <int DK> constexpr int lds_bytes() { return NBUF * SHM_V + NBUF * KVBLK * DK * 2 + 8 * 64 * 4; }
template <int DK> constexpr int ws_off() { return NBUF * SHM_V + NBUF * KVBLK * DK * 2; }
template <int DK, int DKA, bool MASKED, int SDEPTH>
__device__ __forceinline__ void body(const Desc& A, char* lds, const int tid, f32x16 (&o)[4], float& m_reg, float& l_reg, const float C, const float thrs) {
    constexpr int SHM_K = KVBLK * DK * 2, NK0 = DKA / 64, NK1 = (DK - DKA) / 64, NKC = NK0 + NK1, CPR0 = DKA / 8, CPR1 = (DK - DKA) / 8;
    const int wid = __builtin_amdgcn_readfirstlane(tid >> 6), lane = tid & 63, r32 = lane & 31, hi = lane >> 5;
    char* V_lds = lds; char* K_lds = lds + NBUF * SHM_V;
    float* ws = (float*)(lds + ws_off<DK>()) + wid * 64; float* al_l = ws + 32;
    m_reg = -1e30f; l_reg = 0.f;
#pragma unroll
    for (int d = 0; d < 4; ++d) o[d] = f32x16{};
    bf16x8 qr[DK / 16];
    { const int qoff = (wid * QBLK + r32) * (int)A.qstride + hi * 8;
#pragma unroll
      for (int d0 = 0; d0 < DK / 16; ++d0) qr[d0] = (d0 * 16 < DKA) ? *reinterpret_cast<const bf16x8*>(A.q0 + qoff + d0 * 16) : *reinterpret_cast<const bf16x8*>(A.q1 + qoff + (d0 * 16 - DKA)); }
    const int sr = tid >> 4, sc = (tid & 15) * 8, vst0 = v_st(sr, sc), vst1 = v_st(32 + sr, sc);
    const int vb0 = (int)(uintptr_t)V_lds + v_rd_base(lane);
    const int voff0 = sr * (int)A.vstride + sc, voff1 = (32 + sr) * (int)A.vstride + sc;
    int koff[NKC], kdst[NKC];
#pragma unroll
    for (int i = 0; i < NK0; ++i) { const int c = tid + 512 * i, row = c / CPR0, col = (c % CPR0) * 8; koff[i] = row * (int)A.k0stride + col; kdst[i] = kswz<DK>(row, col * 2); }
#pragma unroll
    for (int i = 0; i < NK1; ++i) { const int c = tid + 512 * i, row = c / (CPR1 ? CPR1 : 1), col = (c % (CPR1 ? CPR1 : 1)) * 8; koff[NK0 + i] = row * (int)A.k1stride + col; kdst[NK0 + i] = kswz<DK>(row, (DKA + col) * 2); }
    struct { bf16x8 vs0, vs1; bf16x8 ks[NKC]; } sr_[SDEPTH];
    const int qp = A.qpos0 + wid * QBLK + r32, wq0 = A.qpos0 + wid * QBLK;
#define FA_SLOAD(i, t) do { const long kp_ = (long)(t) * KVBLK; const bf16* vt_ = A.v + kp_ * A.vstride; const bf16* k0t_ = A.k0 + kp_ * A.k0stride; const bf16* k1t_ = A.k1 + kp_ * A.k1stride; \
    sr_[i].vs0 = *reinterpret_cast<const bf16x8*>(vt_ + voff0); sr_[i].vs1 = *reinterpret_cast<const bf16x8*>(vt_ + voff1); \
    _Pragma("unroll") for (int c_ = 0; c_ < NKC; ++c_) sr_[i].ks[c_] = *reinterpret_cast<const bf16x8*>((c_ < NK0 ? k0t_ : k1t_) + koff[c_]); } while (0)
#define FA_SWRITE(b, i) do { *(bf16x8*)(V_lds + (b) * SHM_V + vst0) = sr_[i].vs0; *(bf16x8*)(V_lds + (b) * SHM_V + vst1) = sr_[i].vs1; \
    _Pragma("unroll") for (int c_ = 0; c_ < NKC; ++c_) *(bf16x8*)(K_lds + (b) * SHM_K + kdst[c_]) = sr_[i].ks[c_]; } while (0)
#define FA_SWAIT() do { if constexpr (SDEPTH == 2) { if constexpr (NKC == 1) asm volatile("s_waitcnt vmcnt(3)" ::: "memory"); else if constexpr (NKC == 2) asm volatile("s_waitcnt vmcnt(4)" ::: "memory"); else asm volatile("s_waitcnt vmcnt(5)" ::: "memory"); } \
    else asm volatile("s_waitcnt vmcnt(0)" ::: "memory"); } while (0)
#define FA_RESC(a) do { if (__any((a) < 1.f)) { if (hi == 0) al_l[r32] = (a); asm volatile("s_waitcnt lgkmcnt(0)" ::: "memory"); \
    _Pragma("unroll") for (int d = 0; d < 4; ++d) _Pragma("unroll") for (int r = 0; r < 16; ++r) o[d][r] *= al_l[crow(r, hi)]; } } while (0)
#define FA_MASK(P0, P1, t) do { if constexpr (MASKED) band_mask(P0, P1, qp, (t) * KVBLK, hi, A.band, wq0); } while (0)
#define FA_ROT() do { const int t_ = bA; bA = bB; bB = bC; bC = t_; } while (0)
    f32x16 pA0, pA1, pB0, pB1; float mnA, mnB, alA, alB; bf16x8 pa0, pa1, pa2, pa3; const int NT = A.t1 - A.t0, T0 = A.t0;
    constexpr int SE = 0, SO = SDEPTH - 1;
    int bA = 2, bB = 0, bC = 1;
    FA_SLOAD(SE, T0); asm volatile("s_waitcnt vmcnt(0)" ::: "memory");
    __syncthreads();
    FA_SWRITE(0, SE); __syncthreads();
    qkt<DK>(pA0, pA1, K_lds, qr, r32, hi); FA_MASK(pA0, pA1, T0); partialSM(pA0, pA1, m_reg, mnA, alA, C, thrs);
    FA_SLOAD(SO, T0 + 1); if constexpr (SDEPTH == 2) { if (2 < NT) FA_SLOAD(SE, T0 + 2); }
    FA_SWAIT(); FA_SWRITE(1, SO); __syncthreads();
    FA_ROT();
    for (int j = 1; j + 1 < NT; j += 2) {
        FA_SBAR(); qkt<DK>(pB0, pB1, K_lds + bB * SHM_K, qr, r32, hi);
        finishSM(pA0, pA1, alA, l_reg, pa0, pa1, pa2, pa3); FA_SBAR();
        FA_SLOAD(SO, T0 + j + SDEPTH); FA_SBAR();
        pv_d0<PVPIPE_BODY(DK, MASKED)>(o, vb0 + bA * SHM_V, pa0, pa1, pa2, pa3); FA_MASK(pB0, pB1, T0 + j); partialSM(pB0, pB1, m_reg, mnB, alB, C, thrs);
        FA_SWAIT(); FA_SWRITE(bC, SE);
        FA_RESC(alB); __syncthreads(); FA_ROT();
        FA_SBAR(); qkt<DK>(pA0, pA1, K_lds + bB * SHM_K, qr, r32, hi);
        finishSM(pB0, pB1, alB, l_reg, pa0, pa1, pa2, pa3); FA_SBAR();
        if (SDEPTH == 1 || j + 3 < NT) FA_SLOAD(SE, T0 + j + 1 + SDEPTH); FA_SBAR();
        pv_d0<PVPIPE_BODY(DK, MASKED)>(o, vb0 + bA * SHM_V, pa0, pa1, pa2, pa3); FA_MASK(pA0, pA1, T0 + j + 1); partialSM(pA0, pA1, m_reg, mnA, alA, C, thrs);
        FA_SWAIT(); FA_SWRITE(bC, SO);
        FA_RESC(alA); __syncthreads(); FA_ROT();
    }
    FA_SBAR(); qkt<DK>(pB0, pB1, K_lds + bB * SHM_K, qr, r32, hi);
    finishSM(pA0, pA1, alA, l_reg, pa0, pa1, pa2, pa3); FA_SBAR();
    pv_d0<PVPIPE_BODY(DK, MASKED)>(o, vb0 + bA * SHM_V, pa0, pa1, pa2, pa3); FA_MASK(pB0, pB1, T0 + NT - 1); partialSM(pB0, pB1, m_reg, mnB, alB, C, thrs);
    FA_RESC(alB);
    finishSM(pB0, pB1, alB, l_reg, pa0, pa1, pa2, pa3); FA_SBAR();
    pv_d0<PVPIPE_BODY(DK, MASKED)>(o, vb0 + bB * SHM_V, pa0, pa1, pa2, pa3);
#undef FA_SLOAD
#undef FA_SWRITE
#undef FA_SWAIT
#undef FA_RESC
#undef FA_MASK
#undef FA_ROT
}
template <int DK, bool MASKED, bool PRESC = false, bool SAFE = false>
__device__ __forceinline__ void body_dma(const Desc& A, char* lds, const int tid, f32x16 (&o)[4], float& m_reg, float& l_reg, const float C, const float thrs) {
    constexpr int SHM_K = KVBLK * DK * 2, NKC = DK / 64, CPR = DK / 8;
    const int wid = __builtin_amdgcn_readfirstlane(tid >> 6), lane = tid & 63, r32 = lane & 31, hi = lane >> 5;
    char* V_lds = lds; char* K_lds = lds + NBUF * SHM_V;
    __attribute__((address_space(3))) char* l3 = (__attribute__((address_space(3))) char*)lds;
    float* ws = (float*)(lds + ws_off<DK>()) + wid * 64; float* al_l = ws + 32;
    m_reg = -1e30f; l_reg = 0.f;
#pragma unroll
    for (int d = 0; d < 4; ++d) o[d] = f32x16{};
    bf16x8 qr[DK / 16];
    { const int qoff = (wid * QBLK + r32) * (int)A.qstride + hi * 8;
#pragma unroll
      for (int d0 = 0; d0 < DK / 16; ++d0) qr[d0] = *reinterpret_cast<const bf16x8*>(A.q0 + qoff + d0 * 16); }
    int vsrc[2], ksrc[NKC];
#pragma unroll
    for (int i = 0; i < 2; ++i) { const int g = wid * 64 + i * 512 + lane, sub = g >> 5, w = g & 31, kk = (sub >> 2) * 8 + (w >> 2), k = (kk & ~0xC) | ((kk & 4) << 1) | ((kk & 8) >> 1), c = (sub & 3) * 32 + (w & 3) * 8;
        vsrc[i] = k * (int)A.vstride + c; }
#pragma unroll
    for (int i = 0; i < NKC; ++i) { const int g = wid * 64 + i * 512 + lane, row = g / CPR, ch = g % CPR, sch = ch ^ (row & 7); ksrc[i] = row * (int)A.k0stride + sch * 8; }
    const int vb0 = (int)(uintptr_t)V_lds + v_rd_base(lane);
    const int qp = A.qpos0 + wid * QBLK + r32, wq0 = A.qpos0 + wid * QBLK;
#define FA_DMA(slot, t) do { const long kp_ = (long)(t) * KVBLK; const bf16* vt_ = A.v + kp_ * A.vstride; const bf16* kt_ = A.k0 + kp_ * A.k0stride; \
    _Pragma("unroll") for (int i_ = 0; i_ < 2; ++i_) __builtin_amdgcn_global_load_lds((const unsigned*)(vt_ + (unsigned)vsrc[i_]), (__attribute__((address_space(3))) unsigned*)(l3 + (slot) * SHM_V + wid * 1024 + i_ * 8192), 16, 0, 0); \
    _Pragma("unroll") for (int i_ = 0; i_ < NKC; ++i_) __builtin_amdgcn_global_load_lds((const unsigned*)(kt_ + (unsigned)ksrc[i_]), (__attribute__((address_space(3))) unsigned*)(l3 + NBUF * SHM_V + (slot) * SHM_K + wid * 1024 + i_ * 8192), 16, 0, 0); } while (0)
#define FA_RESC(a) do { if (__any((a) < 1.f)) { if (hi == 0) al_l[r32] = (a); asm volatile("s_waitcnt lgkmcnt(0)" ::: "memory"); \
    _Pragma("unroll") for (int d = 0; d < 4; ++d) _Pragma("unroll") for (int r = 0; r < 16; ++r) o[d][r] *= al_l[crow(r, hi)]; } } while (0)
#define FA_MASK(P0, P1, t) do { if constexpr (MASKED) band_mask(P0, P1, qp, (t) * KVBLK, hi, A.band, wq0); } while (0)
#define FA_ROT() do { const int t_ = bA; bA = bB; bB = bC; bC = t_; } while (0)
#define FA_CLOSE() do { asm volatile("s_waitcnt vmcnt(0)" ::: "memory"); __syncthreads(); } while (0)
    f32x16 negm = f32x16{}; asm volatile("" : "+v"(negm));
#define FA_QKT(P0, P1, KS) do { if constexpr (PRESC) qkt_c<DK>(P0, P1, (KS), qr, negm, r32, hi); else qkt<DK>(P0, P1, (KS), qr, r32, hi); } while (0)
#define FA_PVPSM(P0, P1, AL, MN, t) do { if constexpr (PRESC && (PVX != 0)) { if constexpr (SAFE) pv_psm<true, true>(o, vb0 + bA * SHM_V, pa0, pa1, pa2, pa3, P0, P1, m_reg, negm, AL, thrs, l_reg, qp - (t) * KVBLK - 4 * hi, A.band);     \
      else { FA_MASK(P0, P1, t); pv_psm<false, false>(o, vb0 + bA * SHM_V, pa0, pa1, pa2, pa3, P0, P1, m_reg, negm, AL, thrs, l_reg); } } \
    else { pv_d0<true>(o, vb0 + bA * SHM_V, pa0, pa1, pa2, pa3); FA_MASK(P0, P1, t); FA_PSM(P0, P1, MN, AL, false); } } while (0)
#define FA_PSM(P0, P1, MN, AL, FIRST) do { if constexpr (PRESC) partialSM_pre<FIRST, SAFE>(P0, P1, m_reg, negm, AL, thrs, l_reg); else partialSM(P0, P1, m_reg, MN, AL, C, thrs); } while (0)
    f32x16 pA0, pA1, pB0, pB1; float mnA, mnB, alA, alB; bf16x8 pa0, pa1, pa2, pa3; const int NT = A.t1 - A.t0, T0 = A.t0;
    int bA = 0, bB = 1, bC = 2;
    __syncthreads();
    FA_DMA(0, T0); FA_DMA(1, T0 + 1);
    FA_CLOSE();
    FA_QKT(pA0, pA1, K_lds); FA_MASK(pA0, pA1, T0); FA_PSM(pA0, pA1, mnA, alA, true);
    for (int j = 1; j + 1 < NT; j += 2) {
        FA_SBAR(); FA_QKT(pB0, pB1, K_lds + bB * SHM_K);
        FA_DMA(bC, T0 + j + 1);
        finishSM(pA0, pA1, alA, l_reg, pa0, pa1, pa2, pa3); FA_SBAR();
        FA_PVPSM(pB0, pB1, alB, mnB, T0 + j);
        FA_RESC(alB); FA_CLOSE(); FA_ROT();
        FA_SBAR(); FA_QKT(pA0, pA1, K_lds + bB * SHM_K);
        if (j + 2 < NT) FA_DMA(bC, T0 + j + 2);
        finishSM(pB0, pB1, alB, l_reg, pa0, pa1, pa2, pa3); FA_SBAR();
        FA_PVPSM(pA0, pA1, alA, mnA, T0 + j + 1);
        FA_RESC(alA); FA_CLOSE(); FA_ROT();
    }
    FA_SBAR(); FA_QKT(pB0, pB1, K_lds + bB * SHM_K);
    finishSM(pA0, pA1, alA, l_reg, pa0, pa1, pa2, pa3); FA_SBAR();
    FA_PVPSM(pB0, pB1, alB, mnB, T0 + NT - 1);
    FA_RESC(alB);
    finishSM(pB0, pB1, alB, l_reg, pa0, pa1, pa2, pa3); FA_SBAR();
    pv_d0<true>(o, vb0 + bB * SHM_V, pa0, pa1, pa2, pa3);
#undef FA_DMA
#undef FA_RESC
#undef FA_MASK
#undef FA_ROT
#undef FA_CLOSE
#undef FA_QKT
#undef FA_PSM
#undef FA_PVPSM
}
template <int DK, int DKA, bool MASKED, bool PRESC = false>
__device__ __forceinline__ void body_sb(const Desc& A, char* lds, const int tid, f32x16 (&o)[4], float& m_reg, float& l_reg, const float C, const float thrs) {
    constexpr int SHM_K = KVBLK * DK * 2, NK0 = DKA / 64, NK1 = (DK - DKA) / 64, NKC = NK0 + NK1, CPR0 = DKA / 8, CPR1 = (DK - DKA) / 8;
    const int wid = __builtin_amdgcn_readfirstlane(tid >> 6), lane = tid & 63, r32 = lane & 31, hi = lane >> 5;
    char* V_lds = lds; char* K_lds = lds + 2 * SHM_V;
    float* ws = (float*)(lds + 2 * SHM_V + 2 * SHM_K) + wid * 64; float* al_l = ws + 32;
    m_reg = -1e30f; l_reg = 0.f;
#pragma unroll
    for (int d = 0; d < 4; ++d) o[d] = f32x16{};
    bf16x8 qr[DK / 16];
    { const int qoff = (wid * QBLK + r32) * A.qstride + hi * 8;
#pragma unroll
      for (int d0 = 0; d0 < DK / 16; ++d0) qr[d0] = (d0 * 16 < DKA) ? *reinterpret_cast<const bf16x8*>(A.q0 + qoff + d0 * 16) : *reinterpret_cast<const bf16x8*>(A.q1 + qoff + (d0 * 16 - DKA)); }
    const int sr = tid >> 4, sc = (tid & 15) * 8, vst0 = v_st(sr, sc), vst1 = v_st(32 + sr, sc);
    const int vb0 = (int)(uintptr_t)V_lds + v_rd_base(lane);
    const int voff0 = sr * A.vstride + sc, voff1 = (32 + sr) * A.vstride + sc;
    int koff[NKC], kdst[NKC];
#pragma unroll
    for (int i = 0; i < NK0; ++i) { const int c = tid + 512 * i, row = c / CPR0, col = (c % CPR0) * 8; koff[i] = row * A.k0stride + col; kdst[i] = kswz<DK>(row, col * 2); }
#pragma unroll
    for (int i = 0; i < NK1; ++i) { const int c = tid + 512 * i, row = c / (CPR1 ? CPR1 : 1), col = (c % (CPR1 ? CPR1 : 1)) * 8; koff[NK0 + i] = row * A.k1stride + col; kdst[NK0 + i] = kswz<DK>(row, (DKA + col) * 2); }
    bf16x8 vs0, vs1, ks[NKC];
    const int qp = A.qpos0 + wid * QBLK + r32, wq0 = A.qpos0 + wid * QBLK;
#define FA_SLOAD1(t) do { const long kp_ = (long)(t) * KVBLK; const bf16* vt_ = A.v + kp_ * A.vstride; const bf16* k0t_ = A.k0 + kp_ * A.k0stride; const bf16* k1t_ = A.k1 + kp_ * A.k1stride; \
    vs0 = *reinterpret_cast<const bf16x8*>(vt_ + voff0); vs1 = *reinterpret_cast<const bf16x8*>(vt_ + voff1); \
    _Pragma("unroll") for (int c_ = 0; c_ < NKC; ++c_) ks[c_] = *reinterpret_cast<const bf16x8*>((c_ < NK0 ? k0t_ : k1t_) + koff[c_]); } while (0)
#define FA_SWRITE1(b) do { *(bf16x8*)(V_lds + (b) * SHM_V + vst0) = vs0; *(bf16x8*)(V_lds + (b) * SHM_V + vst1) = vs1; \
    _Pragma("unroll") for (int c_ = 0; c_ < NKC; ++c_) *(bf16x8*)(K_lds + (b) * SHM_K + kdst[c_]) = ks[c_]; } while (0)
    f32x16 negm = f32x16{}; asm volatile("" : "+v"(negm));
    const int NT = A.t1 - A.t0, T0 = A.t0;
    FA_SLOAD1(T0); asm volatile("s_waitcnt vmcnt(0)" ::: "memory");
    __syncthreads();
    FA_SWRITE1(0); __syncthreads();
    for (int j = 0; j < NT; ++j) {
        const int bsel = j & 1;
        if (j + 1 < NT) FA_SLOAD1(T0 + j + 1);
        FA_SBAR();
        f32x16 p0, p1; float mn, al; bf16x8 pa0, pa1, pa2, pa3;
        if constexpr (PRESC) qkt_c<DK>(p0, p1, K_lds + bsel * SHM_K, qr, negm, r32, hi); else qkt<DK>(p0, p1, K_lds + bsel * SHM_K, qr, r32, hi);
        if constexpr (MASKED) band_mask(p0, p1, qp, (T0 + j) * KVBLK, hi, A.band, wq0);
        if constexpr (PRESC) { if (j == 0) partialSM_pre<true>(p0, p1, m_reg, negm, al, thrs); else partialSM_pre<false>(p0, p1, m_reg, negm, al, thrs); }
        else partialSM(p0, p1, m_reg, mn, al, C, thrs);
        finishSM(p0, p1, al, l_reg, pa0, pa1, pa2, pa3);
        if (__any(al < 1.f)) { if (hi == 0) al_l[r32] = al; asm volatile("s_waitcnt lgkmcnt(0)" ::: "memory");
#pragma unroll
            for (int d = 0; d < 4; ++d)
#pragma unroll
                for (int r = 0; r < 16; ++r) o[d][r] *= al_l[crow(r, hi)]; }
        FA_SBAR();
        pv_d0<PVPIPE_SB>(o, vb0 + bsel * SHM_V, pa0, pa1, pa2, pa3);
        if (j + 1 < NT) { asm volatile("s_waitcnt vmcnt(0)" ::: "memory"); FA_SWRITE1(bsel ^ 1); }
        __syncthreads();
    }
#undef FA_SLOAD1
#undef FA_SWRITE1
}
__device__ __forceinline__ void row_bcast(float x, float* ws, int r32, int hi, float (&out)[16]) {
    asm volatile("s_waitcnt lgkmcnt(0)" ::: "memory");
    if (hi == 0) ws[r32] = x; asm volatile("s_waitcnt lgkmcnt(0)" ::: "memory");
#pragma unroll
    for (int r = 0; r < 16; ++r) out[r] = ws[crow(r, hi)];
    asm volatile("s_waitcnt lgkmcnt(0)" ::: "memory");
}
}
constexpr float LOG2E = 1.4426950408889634f;
constexpr float FA_THR = 8.0f;
__device__ __forceinline__ void fa_store_bf16(const fa::f32x16 (&o)[4], const float (&f)[16], bf16* dst, long pitch, int r32, int hi) {
#pragma unroll
    for (int r = 0; r < 16; ++r) { bf16* rp = dst + (long)fa::crow(r, hi) * pitch + r32;
#pragma unroll
        for (int d0 = 0; d0 < 4; ++d0) rp[32 * d0] = (bf16)f2bf(o[d0][r] * f[r]); }
}
__device__ __forceinline__ void unit_mla(int b, int h, int qb, const bf16* QM, int qn0, int qns, int qr0, int qrs, const bf16* KVM, const bf16* U, bf16* Y, char* lds, int tid_in) {
    const int wid = __builtin_amdgcn_readfirstlane(tid_in >> 6), tid = wid * 64 + fresh_lane();
    fa::Desc A; const long row0 = (long)b * SEQ + qb * 256, kb = (long)b * SEQ;
    A.q0 = QM + row0 * NUQP + qn0 + h * qns; A.q1 = QM + row0 * NUQP + qr0 + h * qrs; A.qstride = NUQP;
    A.k0 = KVM + kb * NUKV + h * 256; A.k0stride = NUKV; A.k1 = U + kb * NINP + UC_KR; A.k1stride = NINP;
    A.v = KVM + kb * NUKV + h * 256 + 128; A.vstride = NUKV;
    A.t0 = 0; A.t1 = 4 * (qb + 1); A.qpos0 = qb * 256; A.band = 1 << 30;
    constexpr float SC = 0.07216878364870322f;
    fa::f32x16 o[4]; float m, l; fa::body_sb<192, 128, true, (PRESC_MLA != 0)>(A, lds, tid, o, m, l, PRESC_MLA ? 1.0f : SC * LOG2E, PRESC_MLA ? FA_THR * LOG2E : FA_THR / SC);
    { const int le = fresh_lane(), r32 = le & 31, hi = le >> 5;
    float* ws = (float*)(lds + 2 * fa::SHM_V + 2 * 64 * 192 * 2) + wid * 64; float rl[16]; fa::row_bcast(1.0f / l, ws, r32, hi, rl);
    fa_store_bf16(o, rl, Y + (row0 + wid * 32) * DM + 512 + h * 128, DM, r32, hi); }
}
__device__ __forceinline__ void unit_diff(int b, int h, int qb, const bf16* U, float* A1, bf16* Y, const float* subln, float lam, float lam_init, char* lds, int tid_in) {
    const int wid = __builtin_amdgcn_readfirstlane(tid_in >> 6), tid = wid * 64 + fresh_lane();
    const long row0 = (long)b * SEQ + qb * 256, kb = (long)b * SEQ;
    float* ws = (float*)(lds + fa::ws_off<64>()) + wid * 64;
    constexpr float SC = 0.125f;
    for (int pass = 0; pass < 2; ++pass) {
        fa::Desc A;
        A.q0 = U + row0 * NINP + (pass ? UC_Q2 : UC_Q1) + h * 64; A.q1 = A.q0; A.qstride = NINP;
        A.k0 = U + kb * NINP + (pass ? UC_K2 : UC_K1) + h * 64; A.k0stride = NINP; A.k1 = A.k0; A.k1stride = NINP;
        A.v = U + kb * NINP + UC_VA + h * 128; A.vstride = NINP;
        A.t0 = 0; A.t1 = 4 * (qb + 1); A.qpos0 = qb * 256; A.band = 1 << 30;
        fa::f32x16 o[4]; float m, l; if constexpr (DMA_DIFF != 0) fa::body_dma<64, true, (PRESC_DIFF != 0)>(A, lds, tid, o, m, l, PRESC_DIFF ? 1.0f : SC * LOG2E, PRESC_DIFF ? FA_THR * LOG2E : FA_THR / SC); else fa::body<64, 64, true, 2>(A, lds, tid, o, m, l, SC * LOG2E, FA_THR / SC);
        const int lane = fresh_lane(), r32 = lane & 31, hi = lane >> 5;
        float rl[16]; fa::row_bcast(1.0f / l, ws, r32, hi, rl);
        float* a1p = A1 + (row0 + wid * 32) * 512 + h * 128 + r32;
        if (pass == 0) {
#pragma unroll
            for (int r = 0; r < 16; ++r)
#pragma unroll
                for (int d0 = 0; d0 < 4; ++d0) a1p[(long)fa::crow(r, hi) * 512 + 32 * d0] = o[d0][r] * rl[r];
        } else {
            float sg[4];
#pragma unroll
            for (int d0 = 0; d0 < 4; ++d0) sg[d0] = subln[32 * d0 + r32] * (1.0f - lam_init);
#pragma unroll
            for (int r = 0; r < 16; ++r) { float ss = 0.f;
#pragma unroll
                for (int d0 = 0; d0 < 4; ++d0) { const float x = a1p[(long)fa::crow(r, hi) * 512 + 32 * d0] - lam * (o[d0][r] * rl[r]); o[d0][r] = x; ss += x * x; }
#pragma unroll
                for (int s = 1; s < 32; s <<= 1) ss += lane_xor(ss, lane, s);
                rl[r] = 1.0f / sqrtf(ss * (1.0f / 128.0f) + 1e-5f); }
#pragma unroll
            for (int r = 0; r < 16; ++r)
#pragma unroll
                for (int d0 = 0; d0 < 4; ++d0) o[d0][r] *= sg[d0];
            fa_store_bf16(o, rl, Y + (row0 + wid * 32) * DM + h * 128, DM, r32, hi);
        }
    }
}
__device__ __forceinline__ void unit_dil(int g, int b, int h, int ub, const bf16* U, bf16* OD, float* LSE, char* lds, int tid_in) {
    const int wid = __builtin_amdgcn_readfirstlane(tid_in >> 6), tid = wid * 64 + fresh_lane();
    const int dil = (g == 0) ? 1 : (g == 1) ? 4 : 16, res = ub % dil, m0 = 256 * (ub / dil);
    const long base = (long)b * SEQ + res;
    fa::Desc A;
    A.q0 = U + (base + (long)m0 * dil) * NINP + UC_QC + h * 128; A.q1 = A.q0; A.qstride = dil * NINP;
    A.k0 = U + base * NINP + UC_KC + h * 128; A.k0stride = dil * NINP; A.k1 = A.k0; A.k1stride = A.k0stride;
    A.v = U + base * NINP + UC_VC + h * 128; A.vstride = dil * NINP;
    A.t0 = (m0 >= 128) ? (m0 - 128) / 64 : 0; A.t1 = (m0 + 256) / 64; A.qpos0 = m0; A.band = 128;
    constexpr float SC = 0.08838834764831845f;
    fa::f32x16 o[4]; float m, l; if constexpr (DMA_DIL != 0) fa::body_dma<128, true, (PRESC_DIL != 0), true>(A, lds, tid, o, m, l, PRESC_DIL ? 1.0f : SC * LOG2E, PRESC_DIL ? FA_THR * LOG2E : FA_THR / SC); else fa::body<128, 128, true, 2>(A, lds, tid, o, m, l, SC * LOG2E, FA_THR / SC);
    const int le = fresh_lane(), r32 = le & 31, hi = le >> 5;
    float* ws = (float*)(lds + fa::ws_off<128>()) + wid * 64; float rl[16]; fa::row_bcast(1.0f / l, ws, r32, hi, rl);
    bf16* od = OD + (size_t)g * M * 768;
    const long tok0 = base + (long)(m0 + wid * 32) * dil;
#pragma unroll
    for (int r = 0; r < 16; ++r) { bf16* rp = od + (tok0 + (long)fa::crow(r, hi) * dil) * 768 + h * 128 + r32;
#pragma unroll
        for (int d0 = 0; d0 < 4; ++d0) rp[32 * d0] = (bf16)f2bf(o[d0][r] * rl[r]); }
    if (hi == 0) LSE[(size_t)g * M * 8 + (tok0 + (long)r32 * dil) * 8 + h] = m * (PRESC_DIL ? (1.0f / LOG2E) : SC) + __logf(l);
}
__device__ __forceinline__ void dil_merge(const bf16* OD, const float* LSE, bf16* Y, int it0, int itend, int gsize) {
    for (int it = it0; it < itend; it += gsize) { const int m = it / 96, c8 = (it % 96) * 8, h = c8 >> 7;
        const float l0 = LSE[(size_t)m * 8 + h], l1 = LSE[(size_t)M * 8 + (size_t)m * 8 + h], l2 = LSE[(size_t)2 * M * 8 + (size_t)m * 8 + h];
        const float mx = fmaxf(l0, fmaxf(l1, l2)); float w0 = __expf(l0 - mx), w1 = __expf(l1 - mx), w2 = __expf(l2 - mx); const float inv = 1.0f / (w0 + w1 + w2); w0 *= inv; w1 *= inv; w2 *= inv;
        const v4u p0 = *(const v4u*)(OD + (size_t)m * 768 + c8), p1 = *(const v4u*)(OD + (size_t)M * 768 + (size_t)m * 768 + c8), p2 = *(const v4u*)(OD + (size_t)2 * M * 768 + (size_t)m * 768 + c8);
        v4u o;
#pragma unroll
        for (int i = 0; i < 4; ++i) o[i] = pk2(bflo(p0[i]) * w0 + bflo(p1[i]) * w1 + bflo(p2[i]) * w2, bfhi(p0[i]) * w0 + bfhi(p1[i]) * w1 + bfhi(p2[i]) * w2);
        *(v4u*)(Y + (size_t)m * DM + 1280 + c8) = o; }
}
__device__ __forceinline__ void unit_cross(int rb, int h, const bf16* CQ2, const bf16* KVC, bf16* OC, char* lds, int tid_in) {
    const int wid = __builtin_amdgcn_readfirstlane(tid_in >> 6), tid = wid * 64 + fresh_lane();
    const long row0 = (long)rb * 256; const int b = rb / (SEQ / 256);
    fa::Desc A;
    A.q0 = CQ2 + row0 * 512 + h * 128; A.q1 = A.q0; A.qstride = 512;
    A.k0 = KVC + (long)b * MEML * 1024 + h * 128; A.k0stride = 1024; A.k1 = A.k0; A.k1stride = 1024;
    A.v = A.k0 + 512; A.vstride = 1024;
    A.t0 = 0; A.t1 = MEML / 64; A.qpos0 = 0; A.band = 1 << 30;
    constexpr float SC = 0.08838834764831845f;
    fa::f32x16 o[4]; float m, l; if constexpr (DMA_CROSS != 0) fa::body_dma<128, false, (PRESC_CROSS != 0)>(A, lds, tid, o, m, l, PRESC_CROSS ? 1.0f : SC * LOG2E, PRESC_CROSS ? FA_THR * LOG2E : FA_THR / SC); else fa::body<128, 128, false, 2>(A, lds, tid, o, m, l, SC * LOG2E, FA_THR / SC);
    const int le = fresh_lane(), r32 = le & 31, hi = le >> 5;
    float* ws = (float*)(lds + fa::ws_off<128>()) + wid * 64; float rl[16]; fa::row_bcast(1.0f / l, ws, r32, hi, rl);
    fa_store_bf16(o, rl, OC + (row0 + wid * 32) * 512 + h * 128, 512, r32, hi);
}
constexpr int NU_CAUSAL = 16 * 40, NU_DIL = 3 * 24 * 16, NU_MIX = NU_CAUSAL + NU_DIL;

__device__ __noinline__ void grid_bar(GAS unsigned* barw, unsigned x, volatile LAS unsigned* st, int leader) { XcdBarrier b; b.bar = (unsigned*)barw; b.x = x; b.st = st; xcd_barrier(b, leader != 0); }
__device__ __noinline__ void local_bar(GAS unsigned* lbw, unsigned x, unsigned nloc, int leader) {
    asm volatile("s_waitcnt vmcnt(0)" ::: "memory");
    __syncthreads();
    if (leader) {
        unsigned* b = (unsigned*)lbw;
        __builtin_amdgcn_s_waitcnt(0);
        const unsigned old = xb_add(&b[XB_XCNT(x)], 1u), tgt = (old / nloc + 1u) * nloc;
        if (old + 1u != tgt) XB_SPIN(xb_ld(&b[XB_XCNT(x)]) < tgt, b);
        __builtin_amdgcn_fence(__ATOMIC_ACQUIRE, "agent");
        asm volatile("s_waitcnt vmcnt(0)" ::: "memory");
    }
    __syncthreads();
}
__device__ __forceinline__ void wg_publish(gu32* ctr, int leader) {
    asm volatile("s_waitcnt vmcnt(0)" ::: "memory"); __syncthreads();
    if (leader) { __builtin_amdgcn_fence(__ATOMIC_RELEASE, "agent"); asm volatile("s_waitcnt vmcnt(0)" ::: "memory"); (void)__hip_atomic_fetch_add(ctr, 1u, RLX_AGENT); }
}
__device__ __forceinline__ void wg_wait(gu32* ctr, unsigned target, int leader) {
    if (leader) { unsigned sp = 0; while (__hip_atomic_load(ctr, RLX_AGENT) < target) { __builtin_amdgcn_s_sleep(1); if (++sp > (1u << 22)) break; }
        __builtin_amdgcn_fence(__ATOMIC_ACQUIRE, "agent"); asm volatile("s_waitcnt vmcnt(0)" ::: "memory"); }
    __syncthreads();
}
__device__ __forceinline__ void final_norm_hilo(const bf16* HB, const bf16* LO, float* out, const float* g, int m0, int mend, int NGW, int lane) {
    for (int m = m0; m < mend; m += NGW) {
        float v[4][8]; float s = 0.f;
#pragma unroll
        for (int j = 0; j < 4; ++j) { const v4u h = *(const v4u*)(HB + (size_t)m * DM + 512 * j + 8 * lane); v4u l = {0u, 0u, 0u, 0u}; if (LO) l = *(const v4u*)(LO + (size_t)m * DM + 512 * j + 8 * lane);
#pragma unroll
            for (int i = 0; i < 4; ++i) { v[j][2 * i] = bflo(h[i]) + bflo(l[i]); v[j][2 * i + 1] = bfhi(h[i]) + bfhi(l[i]); s += v[j][2 * i] * v[j][2 * i] + v[j][2 * i + 1] * v[j][2 * i + 1]; } }
        const float rstd = 1.0f / sqrtf(wave_sum(s, lane) * (1.0f / DM) + 1e-6f);
#pragma unroll
        for (int j = 0; j < 4; ++j) { const f32x4 g0 = *(const f32x4*)(g + 512 * j + 8 * lane), g1 = *(const f32x4*)(g + 512 * j + 8 * lane + 4);
            f32x4 o0, o1; o0.x = v[j][0] * rstd * g0.x; o0.y = v[j][1] * rstd * g0.y; o0.z = v[j][2] * rstd * g0.z; o0.w = v[j][3] * rstd * g0.w;
            o1.x = v[j][4] * rstd * g1.x; o1.y = v[j][5] * rstd * g1.y; o1.z = v[j][6] * rstd * g1.z; o1.w = v[j][7] * rstd * g1.w;
            *(f32x4*)(out + (size_t)m * DM + 512 * j + 8 * lane) = o0; *(f32x4*)(out + (size_t)m * DM + 512 * j + 8 * lane + 4) = o1; }
    }
}
#ifndef LOCAL_SEAMS
#define LOCAL_SEAMS 1
#endif
#ifndef ST_SWIGLU
#define ST_SWIGLU 1
#endif
#ifndef ST_NORM
#define ST_NORM 1
#endif
#ifndef ST_HILO
#define ST_HILO 1
#endif
#ifndef ST_MIX
#define ST_MIX 1
#endif
#ifndef PROBE_DUP
#define PROBE_DUP (-100)
#endif
#define REPS(slot) (((slot) == PROBE_DUP) ? 2 : 1)
constexpr int NPL = 20;
constexpr int PH_TOTAL = 1 + DEPTH * NPL + 1;
enum { RM_ID = 0, RM_GU = 1, RM_WINPAD = 2, RM_WIN = 3, RM_UQ = 4 };
template <int MODE> __device__ __forceinline__ int row_map(int n, int off) {
    if (MODE == RM_GU) return (n >> 7) * 256 + off + (n & 127);
    if (MODE == RM_WINPAD) return n < 2624 ? n : n + 192;
    if (MODE == RM_WIN) { const int cp = n < 2624 ? n : n + 192, t = cp >> 8, c = cp & 255, k = pg8::win_kind(t); return t * 256 + (k == 2 ? pg8::rope_perm64(c) : k == 3 ? pg8::rope_perm128(c) : c); }
    if (MODE == RM_UQ) { const int h = n / 192, w = n % 192; if (w < 128) return h * 128 + w; const int r = w - 128; return (3 + (h >> 2)) * 256 + (r >> 5) * 128 + (h & 3) * 32 + (r & 31); }
    return n + off;
}
__device__ __forceinline__ void conv_load(float (&v)[32], const float* W, int N, int nblk, int item, int lane) {
    const int kb = item / nblk, nb = item % nblk; const float* p = W + (size_t)(64 * kb + (lane >> 5)) * N + 32 * nb + (lane & 31);
#pragma unroll
    for (int i = 0; i < 32; ++i) v[i] = p[(size_t)(2 * i) * N];
}
template <int MODE> __device__ __forceinline__ void conv_store(const float (&v)[32], int K, int nblk, bf16* WT, int off, const float* gain, LAS float* scr, int item, int lane) {
    const int kb = item / nblk, nb = item % nblk, k0 = 64 * kb, n0 = 32 * nb, c = lane & 7;
#pragma unroll
    for (int i = 0; i < 32; ++i) scr[(2 * i + (lane >> 5)) * 33 + (lane & 31)] = v[i];
    float g8[8];
#pragma unroll
    for (int i = 0; i < 8; ++i) g8[i] = gain ? gain[k0 + 8 * c + i] : 1.0f;
    LDS_WAIT(); asm volatile("" ::: "memory");
#pragma unroll
    for (int j = 0; j < 4; ++j) { const int n = (lane >> 3) + 8 * j; const LAS float* s = scr + (8 * c) * 33 + n;
        v4u o; o.x = pk2(s[0 * 33] * g8[0], s[1 * 33] * g8[1]); o.y = pk2(s[2 * 33] * g8[2], s[3 * 33] * g8[3]); o.z = pk2(s[4 * 33] * g8[4], s[5 * 33] * g8[5]); o.w = pk2(s[6 * 33] * g8[6], s[7 * 33] * g8[7]);
        *(GAS v4u*)(WT + (size_t)row_map<MODE>(n0 + n, off) * K + k0 + 8 * c) = o; }
    LDS_WAIT(); asm volatile("" ::: "memory");
}
template <int MODE> __device__ __forceinline__ void conv_matrix(const float* W, int K, int N, bf16* WT, int off, const float* gain, LAS float* scr, int gw, int NGW, int lane) {
    const int nblk = N / 32, nit = (K / 64) * nblk; float va[32], vb[32];
    int it = gw; if (it < nit) conv_load(va, W, N, nblk, it, lane);
    while (it < nit) {
        int nx = it + NGW; if (nx < nit) conv_load(vb, W, N, nblk, nx, lane);
        conv_store<MODE>(va, K, nblk, WT, off, gain, scr, it, lane); it = nx; if (it >= nit) break;
        nx = it + NGW; if (nx < nit) conv_load(va, W, N, nblk, nx, lane);
        conv_store<MODE>(vb, K, nblk, WT, off, gain, scr, it, lane); it = nx;
    }
}
#define CONV2(MODE, Wp, K_, N_, WTp, off, gain) conv_matrix<MODE>((Wp), (K_), (N_), (WTp), (off), (gain), scr, gw, NGW, lane)
template <int NPART> __device__ __forceinline__ void rows_to_bf16_stats(const float* src, bf16* dst, bf16* lo, float* S, int nrows, int gw, int NGW, int lane) {
    for (int m = gw; m < nrows; m += NGW) {
        const f32x4* xr = (const f32x4*)(src + (size_t)m * DM) + lane; f32x4 v[8]; float s = 0.f;
#pragma unroll
        for (int j = 0; j < 8; ++j) { v[j] = xr[64 * j]; s += (v[j].x * v[j].x + v[j].y * v[j].y) + (v[j].z * v[j].z + v[j].w * v[j].w); }
        s = wave_sum(s, lane);
        unsigned long long* o8 = (unsigned long long*)(dst + (size_t)m * DM) + lane;
#pragma unroll
        for (int j = 0; j < 8; ++j) o8[64 * j] = (unsigned long long)pk2(v[j].x, v[j].y) | ((unsigned long long)pk2(v[j].z, v[j].w) << 32);
        if (lo) { unsigned long long* l8 = (unsigned long long*)(lo + (size_t)m * DM) + lane;
#pragma unroll
            for (int j = 0; j < 8; ++j) { const unsigned p0 = pk2(v[j].x, v[j].y), p1 = pk2(v[j].z, v[j].w);
                l8[64 * j] = (unsigned long long)pk2(v[j].x - bflo(p0), v[j].y - bfhi(p0)) | ((unsigned long long)pk2(v[j].z - bflo(p1), v[j].w - bfhi(p1)) << 32); } }
        if (lane < NPART) S[(size_t)m * NPART + lane] = (lane == 0) ? s : 0.f;
    }
}
__global__ void __launch_bounds__(NWAVES * 64, 2) mk_fwd(Params P) {
    extern __shared__ __attribute__((aligned(16))) unsigned char lds_raw[];
    LAS unsigned char* lds = (LAS unsigned char*)lds_raw;
    volatile LAS unsigned* MISC = (volatile LAS unsigned*)(lds + MISC_OFF);
    const int wave_s = __builtin_amdgcn_readfirstlane(threadIdx.x >> 6);
#define IDS int bx = blockIdx.x, G = gridDim.x, wave = wave_s; asm volatile("" : "+s"(bx), "+s"(G), "+s"(wave)); \
    const int lane = fresh_lane(), tid = wave * 64 + lane, gw = bx * NWAVES + wave, NGW = G * NWAVES, gtid = bx * (NWAVES * 64) + tid, gsize = G * NWAVES * 64; \
    const int lok = __builtin_amdgcn_readfirstlane((int)MISC[18]), xcc = __builtin_amdgcn_readfirstlane((int)MISC[16]), xrank = __builtin_amdgcn_readfirstlane((int)MISC[17]); \
    const int cv = lok ? (xrank * 8 + xcc) : bx;     \
    const int pair = lok ? (xcc >> 1) : 0, pidx = lok ? ((xcc & 1) * (G >> 3) + xrank) : bx, PG = lok ? (G >> 2) : G, NQG = lok ? 4 : 1;     \
    (void)lane; (void)gw; (void)NGW; (void)gtid; (void)gsize; (void)cv; (void)xcc; (void)xrank; (void)pair; (void)pidx; (void)PG; (void)NQG;
    typedef const volatile __attribute__((address_space(4))) Params* KArg;
    KArg vp = (KArg)__builtin_amdgcn_kernarg_segment_ptr();
#define PIN(i) ((const float*)vp->in[i])
#define WS (vp->ws)
#define CTLP ((gu32*)(WS + WS_CTL))
    for (int u = threadIdx.x; u < (LDS_BYTES - LDSCTL_OFF) / 4; u += NWAVES * 64) ((LAS unsigned*)(lds + LDSCTL_OFF))[u] = 0u;
    __syncthreads();
    if (P.use_bar && threadIdx.x == 0) { const unsigned x_ = xb_xcc_id(); MISC[17] = xb_add((unsigned*)(CTLP + CW_BAR) + XB_XCNT(x_), 1u); MISC[16] = x_; }
#define IN(k) (vp->ph_lo <= (k) && (k) < vp->ph_hi)
#define SEAM(k) do { if (IN(k) && IN((k) + 1)) { const int ldr_ = (wave_s == 0 && fresh_lane() == 0) ? 1 : 0; grid_bar((GAS unsigned*)(CTLP + CW_BAR), xb_xcc_id(), (volatile LAS unsigned*)(lds + MISC_OFF) + 8, ldr_); } } while (0)
#define SEAM_L(k) do { if (IN(k) && IN((k) + 1)) { const int ldr_ = (wave_s == 0 && fresh_lane() == 0) ? 1 : 0; \
    if (MISC[18]) local_bar((GAS unsigned*)(CTLP + CW_LBAR), (unsigned)__builtin_amdgcn_readfirstlane((int)MISC[16]), gridDim.x / 8u, ldr_); \
    else grid_bar((GAS unsigned*)(CTLP + CW_BAR), xb_xcc_id(), (volatile LAS unsigned*)(lds + MISC_OFF) + 8, ldr_); } } while (0)
#define SEAM_P(k) do { if (IN(k) && IN((k) + 1)) { const int ldr_ = (wave_s == 0 && fresh_lane() == 0) ? 1 : 0; \
    if (MISC[18]) { const unsigned x_ = (unsigned)__builtin_amdgcn_readfirstlane((int)MISC[16]); grid_bar((GAS unsigned*)(CTLP + CW_PBAR) + (x_ >> 1) * XCD_BAR_WORDS, x_, (volatile LAS unsigned*)(lds + MISC_OFF) + 20, ldr_); } \
    else grid_bar((GAS unsigned*)(CTLP + CW_BAR), xb_xcc_id(), (volatile LAS unsigned*)(lds + MISC_OFF) + 8, ldr_); } } while (0)
#define HH (vp->out)
#define WSB(off) ((bf16*)(WS + (off)))
#define WSF(off) ((float*)(WS + (off)))
#define WL(l) (WSB(WS_W) + (size_t)(l) * W_LAYER)
#define RCACHE_DEF(NP, Sp, invn) int pm0_ = 0; { pg8::Unit u0_{0, 0}; if (S.next(0, u0_)) pm0_ = u0_.pm; } const pg8::RstdCache rc_ = pg8::rstd_cache_fill<NP>((LAS float*)(lds + RSTD_OFF), (Sp), pm0_, tid, (invn), 1e-6f);
#define GEMM_PH(EPI, ...) pg8::gemm_phase<EPI, pg8::StaticOrder, true, true>(lds + RING_OFF, g, S, E, tid)

    if (IN(0)) for (int rep = 0; rep < REPS(-1); ++rep) { IDS
        LAS float* scr = (LAS float*)(lds + RING_OFF + wave * 16384);
        for (int l = 0; l < DEPTH; ++l) {
            const float* gF1 = ST_NORM ? PIN(I_F1N) + l * DM : nullptr; const float* gF2 = ST_NORM ? PIN(I_F2N) + l * DM : nullptr; const float* gMX = ST_NORM ? PIN(I_MIXN) + l * DM : nullptr;
            const float* gCR = ST_NORM ? PIN(I_CRN) + l * DM : nullptr; const float* gME = ST_NORM ? PIN(I_MEMN) + l * DM : nullptr;
            const float* gQ = ST_MIX ? PIN(I_QN) + l * 512 : nullptr; const float* gKV = ST_MIX ? PIN(I_KVN) + l * 512 : nullptr;
            constexpr int MGU = ST_SWIGLU ? RM_GU : RM_ID, OFU = ST_SWIGLU ? 128 : FF;
            CONV2(MGU, PIN(I_F1G) + (size_t)l * DM * FF, DM, FF, WL(l) + WO_GU1, 0, gF1);
            CONV2(MGU, PIN(I_F1U) + (size_t)l * DM * FF, DM, FF, WL(l) + WO_GU1, OFU, gF1);
            CONV2(RM_ID, PIN(I_F1D) + (size_t)l * FF * DM, FF, DM, WL(l) + WO_D1, 0, nullptr);
            CONV2((ST_MIX ? RM_WIN : RM_WINPAD), PIN(I_WIN) + (size_t)l * DM * NIN, DM, NIN, WL(l) + WO_IN, 0, gMX);
            CONV2((ST_MIX ? RM_UQ : RM_ID), PIN(I_WUQ) + (size_t)l * 512 * NUQ, 512, NUQ, WL(l) + WO_UQ, 0, gQ);
            CONV2(RM_ID, PIN(I_WUKV) + (size_t)l * 512 * NUKV, 512, NUKV, WL(l) + WO_UKV, 0, gKV);
            CONV2(RM_ID, PIN(I_WOUT) + (size_t)l * DM * DM, DM, DM, WL(l) + WO_OUT, 0, nullptr);
            CONV2(RM_ID, PIN(I_CWQ) + (size_t)l * DM * 512, DM, 512, WL(l) + WO_CQ, 0, gCR);
            CONV2(RM_ID, PIN(I_CWKV) + (size_t)l * DM * 1024, DM, 1024, WL(l) + WO_CKV, 0, gME);
            CONV2(RM_ID, PIN(I_CWO) + (size_t)l * 512 * DM, 512, DM, WL(l) + WO_CO, 0, nullptr);
            CONV2(MGU, PIN(I_F2G) + (size_t)l * DM * FF, DM, FF, WL(l) + WO_GU2, 0, gF2);
            CONV2(MGU, PIN(I_F2U) + (size_t)l * DM * FF, DM, FF, WL(l) + WO_GU2, OFU, gF2);
            CONV2(RM_ID, PIN(I_F2D) + (size_t)l * FF * DM, FF, DM, WL(l) + WO_D2, 0, nullptr);
            for (int it = gtid; it < 192 * DM / 8; it += gsize) { const int rr = it / (DM / 8), c8 = it % (DM / 8), cp = 2624 + rr; const int row = ST_MIX ? (2560 + pg8::rope_perm64(cp - 2560)) : cp;
                *(v4u*)(WL(l) + WO_IN + (size_t)row * DM + (size_t)c8 * 8) = (v4u){0u, 0u, 0u, 0u}; }
            for (int it = gtid; it < 128 * 512 / 8; it += gsize) { const int rr = it / 64, c8 = it % 64; const int row = ST_MIX ? (4 * 256 + (rr >> 6) * 128 + (2 + ((rr >> 5) & 1)) * 32 + (rr & 31)) : (NUQ + rr);
                *(v4u*)(WL(l) + WO_UQ + (size_t)row * 512 + (size_t)c8 * 8) = (v4u){0u, 0u, 0u, 0u}; }
        }
        const int* pos = (const int*)PIN(I_POS);
        for (int it = gtid; it < M * 32; it += gsize) { const int m = it >> 5, i = it & 31; float c, s; sincos_rad((float)pos[m] * vp->inv64[i], c, s); WSF(WS_COS64)[it] = c; WSF(WS_SIN64)[it] = s; }
        for (int it = gtid; it < M * 64; it += gsize) { const int m = it >> 6, i = it & 63; float c, s; sincos_rad((float)pos[m] * vp->inv128[i], c, s); WSF(WS_COS128)[it] = c; WSF(WS_SIN128)[it] = s; }
        if (gtid < DEPTH) { const float* lp = PIN(I_DLAM) + gtid * 256; float a = 0.f, b2 = 0.f;
            for (int i = 0; i < 64; ++i) { a += lp[i] * lp[64 + i]; b2 += lp[128 + i] * lp[192 + i]; }
            WSF(WS_LAM)[gtid] = expf(a) - expf(b2) + vp->lam_init[gtid]; }
#if ST_NORM
        rows_to_bf16_stats<32>(PIN(I_X), WSB(WS_XN), (ST_HILO == 1) ? WSB(WS_LO) : nullptr, WSF(WS_STATS), M, gw, NGW, lane);
        rows_to_bf16_stats<8>(PIN(I_MEM), WSB(WS_MEMB), nullptr, WSF(WS_MSTAT), MMEM, gw, NGW, lane);
#endif
    }
    SEAM(0);
    if (IN(0) && IN(1)) {
        if (wave_s == 0 && fresh_lane() == 0) { const unsigned G_ = gridDim.x; unsigned ok = (G_ % 8u == 0u) ? 1u : 0u;
            for (unsigned j = 0; j < 16; ++j) { const unsigned c_ = xb_ld((unsigned*)(CTLP + CW_BAR) + XB_XCNT(j)); ok &= (j < 8u) ? (c_ == G_ / 8u) : (c_ == 0u); }
            MISC[18] = LOCAL_SEAMS ? ok : 0u; MISC[20] = G_ / 8u; MISC[21] = 2u; }
        __syncthreads();
    }

    for (int l = 0; l < DEPTH; ++l) {
        const int pb = 1 + l * NPL;
#define FFN_PHASES(p0, NRM, WGU, WD, BASE0) \
        if (IN(pb + (p0))) { IDS if (!ST_NORM) nv_norm_rows((BASE0), PIN(NRM) + l * DM, WSB(WS_XN), M, gw, NGW, lane); } \
        if (!ST_NORM) SEAM(pb + (p0)); \
        if (IN(pb + (p0) + 1)) { IDS pg8::Gemm g{WSB(WS_XN), WL(l) + (WGU), M, 2 * FF, DM, DM, DM}; pg8::StaticOrder S; S.init(M, 2 * FF, G, cv); \
            if (ST_SWIGLU) { RCACHE_DEF(32, WSF(WS_STATS), 1.0f / 2048.0f) pg8::EpiSwiglu E{WSB(WS_HID), FF, ST_NORM ? WSF(WS_STATS) : nullptr, rc_}; GEMM_PH(pg8::EpiSwiglu); } \
            else { pg8::EpiBf16 E{WSB(WS_GU), 2 * FF}; GEMM_PH(pg8::EpiBf16); } } \
        if (IN(pb + (p0) + 1) && REPS((p0) + 1) == 2) { IDS pg8::Gemm g{WSB(WS_XN), WL(l) + (WGU), M, 2 * FF, DM, DM, DM}; pg8::StaticOrder S; S.init(M, 2 * FF, G, cv); \
            RCACHE_DEF(32, WSF(WS_STATS), 1.0f / 2048.0f) pg8::EpiSwiglu E{WSB(WS_HID), FF, ST_NORM ? WSF(WS_STATS) : nullptr, rc_}; GEMM_PH(pg8::EpiSwiglu); } \
        SEAM_L(pb + (p0) + 1); \
        if (IN(pb + (p0) + 2)) { IDS if (!ST_SWIGLU) nv_swiglu(WSB(WS_GU), WSB(WS_HID), gtid, gsize); } \
        if (!ST_SWIGLU) SEAM(pb + (p0) + 2); \
        if (IN(pb + (p0) + 3)) for (int rep = 0; rep < REPS((p0) + 3); ++rep) { IDS pg8::Gemm g{WSB(WS_HID), WL(l) + (WD), M, DM, FF, FF, FF}; pg8::StaticOrder S; S.init(M, DM, G, cv); \
            if (ST_HILO) { pg8::EpiResid3 E{WSB(WS_XN), (ST_HILO == 2) ? nullptr : WSB(WS_LO), WSF(WS_STATS), DM, rep ? 0.0f : 0.5f}; GEMM_PH(pg8::EpiResid3); } \
            else if (ST_NORM) { pg8::EpiResid2 E{rep ? (const float*)HH : (BASE0), HH, WSB(WS_XN), WSF(WS_STATS), DM, rep ? 0.0f : 0.5f}; GEMM_PH(pg8::EpiResid2); } \
            else { pg8::EpiResid E{(BASE0), HH, DM, 0.5f}; GEMM_PH(pg8::EpiResid); } } \
        if ((p0) == 16 && l == DEPTH - 1) SEAM_P(pb + (p0) + 3); else SEAM_L(pb + (p0) + 3);
        FFN_PHASES(0, I_F1N, WO_GU1, WO_D1, ((l == 0) ? PIN(I_X) : (const float*)HH))
        if (IN(pb + 4)) { IDS if (!ST_NORM) nv_norm_rows(HH, PIN(I_MIXN) + l * DM, WSB(WS_XN), M, gw, NGW, lane); }
        if (!ST_NORM) SEAM(pb + 4);
        if (IN(pb + 5)) for (int rep = 0; rep < REPS(5); ++rep) { IDS pg8::Gemm g{WSB(WS_XN), WL(l) + WO_IN, M, NINP, DM, DM, DM}; pg8::StaticOrder S; S.init(M, NINP, G, cv);
            if (ST_MIX) { RCACHE_DEF(32, WSF(WS_STATS), 1.0f / 2048.0f) pg8::EpiMix<32> E{WSB(WS_U), NINP, WSF(WS_STATS), 1.0f / 2048.0f, 0, WSF(WS_COS64), WSF(WS_SIN64), WSF(WS_COS128), WSF(WS_SIN128), WSF(WS_SQ), WSF(WS_SKV), rc_, 1.0f}; GEMM_PH(pg8::EpiMix<32>); }
            else { pg8::EpiBf16 E{WSB(WS_U), NINP}; GEMM_PH(pg8::EpiBf16); } }
        SEAM_P(pb + 5);
        if (IN(pb + 6)) { IDS if (!ST_MIX) nv_mix_post(WSB(WS_U), WSF(WS_COS64), WSF(WS_SIN64), WSF(WS_COS128), WSF(WS_SIN128), PIN(I_QN) + l * 512, PIN(I_KVN) + l * 512, WSB(WS_CQN), WSB(WS_CKVN), gw, NGW, lane); }
        if (!ST_MIX) SEAM(pb + 6);
        if (IN(pb + 7)) for (int rep = 0; rep < REPS(7); ++rep) { IDS
            { const int tid = wave * 64 + fresh_lane();     pg8::Gemm g{ST_MIX ? WSB(WS_U) + UC_CQ : WSB(WS_CQN), WL(l) + WO_UQ, M, NUQP, 512, ST_MIX ? NINP : 512, 512}; pg8::StaticOrder S; S.init(M, NUQP, G, cv);
              if (ST_MIX) { RCACHE_DEF(8, WSF(WS_SQ), 1.0f / 512.0f) pg8::EpiMix<8> E{WSB(WS_QM), NUQP, WSF(WS_SQ), 1.0f / 512.0f, 1, WSF(WS_COS64), WSF(WS_SIN64), WSF(WS_COS128), WSF(WS_SIN128), nullptr, nullptr, rc_, PRESC_MLA ? QS_MLA : 1.0f}; GEMM_PH(pg8::EpiMix<8>); }
              else { pg8::EpiBf16 E{WSB(WS_QM), NUQP}; GEMM_PH(pg8::EpiBf16); } }
            { const int tid = wave * 64 + fresh_lane();     pg8::Gemm g{ST_MIX ? WSB(WS_U) + UC_CKV : WSB(WS_CKVN), WL(l) + WO_UKV, M, NUKV, 512, ST_MIX ? NINP : 512, 512}; pg8::StaticOrder S; S.init(M, NUKV, G, cv);
              if (ST_MIX) { RCACHE_DEF(8, WSF(WS_SKV), 1.0f / 512.0f) pg8::EpiMix<8> E{WSB(WS_KVM), NUKV, WSF(WS_SKV), 1.0f / 512.0f, 2, nullptr, nullptr, nullptr, nullptr, nullptr, nullptr, rc_, 1.0f}; GEMM_PH(pg8::EpiMix<8>); }
              else { pg8::EpiBf16 E{WSB(WS_KVM), NUKV}; GEMM_PH(pg8::EpiBf16); } }
            { const int tid = wave * 64 + fresh_lane();     pg8::Gemm g{ST_NORM ? WSB(WS_MEMB) : WSB(WS_MEMN), WL(l) + WO_CKV, MMEM, 1024, DM, DM, DM}; pg8::StaticOrder S; S.init(MMEM, 1024, G, lok ? (pidx < 4 ? ((pair & 1) * 8 + 2 * pidx + (pair >> 1)) : G) : cv);
              if (ST_NORM) { RCACHE_DEF(8, WSF(WS_MSTAT), 1.0f / 2048.0f) pg8::EpiMix<8> E{WSB(WS_KVC), 1024, WSF(WS_MSTAT), 1.0f / 2048.0f, 2, nullptr, nullptr, nullptr, nullptr, nullptr, nullptr, rc_, 1.0f}; GEMM_PH(pg8::EpiMix<8>); }
              else { pg8::EpiBf16 E{WSB(WS_KVC), 1024}; GEMM_PH(pg8::EpiBf16); } }
            { char* lp = (char*)lds_raw + RING_OFF; gu32* qctr = CTLP + CW_Q + 64 * ((l + DEPTH * rep) * 4 + pair); gu32* gctr = CTLP + CW_Q + 64 * ((8 + l + DEPTH * rep) * 4 + pair);
              const float lam = WSF(WS_LAM)[l], lami = vp->lam_init[l];
              { const int ldr_ = (wave == 0 && fresh_lane() == 0) ? 1 : 0; wg_publish(gctr, ldr_); }
              int cur = pidx, gready = 0; const int nca = NU_CAUSAL / NQG, ndf = nca * 2 / 5, nq = (NU_CAUSAL + NU_DIL) / NQG;
              while (cur < nq) {
                  const int tidu = wave * 64 + fresh_lane();
                  if (tidu == 0) MISC[12] = __hip_atomic_fetch_add(qctr, 1u, RLX_AGENT) + (unsigned)PG;
                  if (cur < ndf) {
                      int qb, bb, hh;
                      if (lok) { qb = 15 - (cur >> 2); bb = pair; hh = cur & 3; } else { qb = 15 - (cur >> 4); bb = (cur >> 2) & 3; hh = cur & 3; }
                      unit_diff(bb, hh, qb, WSB(WS_U), WSF(WS_A1), WSB(WS_Y), PIN(I_DSUB) + l * 128, lam, lami, lp, tidu);
                  } else if (cur < nca) {
                      if (!gready) { wg_wait(gctr, (unsigned)PG, (tidu == 0) ? 1 : 0); gready = 1; }
                      const int c2 = cur - ndf; int qb, bb, hh;
                      if (lok) { qb = 15 - c2 / 6; bb = pair; hh = c2 % 6; } else { qb = 15 - c2 / 24; const int w = c2 % 24; bb = w / 6; hh = w % 6; }
                      unit_mla(bb, hh, qb, WSB(WS_QM), 0, ST_MIX ? 128 : 192, ST_MIX ? 768 : 128, ST_MIX ? 64 : 192, WSB(WS_KVM), WSB(WS_U), WSB(WS_Y), lp, tidu);
                  } else {
                      const int cd = cur - nca; int g, bb, hh, ub;
                      if (lok) { g = cd / 96; const int rem = cd % 96; bb = pair; hh = rem >> 4; ub = rem & 15; }
                      else { g = cd / 384; const int rem = cd % 384, bh = rem >> 4; bb = bh / 6; hh = bh % 6; ub = rem & 15; }
                      unit_dil(g, bb, hh, ub, WSB(WS_U), WSB(WS_OD), WSF(WS_LSE), lp, tidu);
                  }
                  __syncthreads(); cur = __builtin_amdgcn_readfirstlane((int)MISC[12]); __syncthreads();
              } }
        }
        SEAM_P(pb + 7);
        if (IN(pb + 8)) { IDS if (!ST_MIX) nv_mla_post(WSB(WS_QM), WSF(WS_COS64), WSF(WS_SIN64), gw, NGW, lane); }
        if (!ST_MIX) SEAM(pb + 8);
        if (IN(pb + 9)) for (int rep = 0; rep < REPS(9); ++rep) { IDS
            dil_merge(WSB(WS_OD), WSF(WS_LSE), WSB(WS_Y), pair * (SEQ * 96) + pidx * (NWAVES * 64) + tid, lok ? (pair + 1) * (SEQ * 96) : M * 96, PG * (NWAVES * 64));
        }
        SEAM_P(pb + 9);
        if (IN(pb + 11)) for (int rep = 0; rep < REPS(11); ++rep) { IDS pg8::Gemm g{WSB(WS_Y), WL(l) + WO_OUT, M, DM, DM, DM, DM}; pg8::StaticOrder S; S.init(M, DM, G, cv);
            if (ST_HILO) { pg8::EpiResid3 E{WSB(WS_XN), (ST_HILO == 2) ? nullptr : WSB(WS_LO), WSF(WS_STATS), DM, rep ? 0.0f : 1.0f}; GEMM_PH(pg8::EpiResid3); }
            else if (ST_NORM) { pg8::EpiResid2 E{HH, HH, WSB(WS_XN), WSF(WS_STATS), DM, rep ? 0.0f : 1.0f}; GEMM_PH(pg8::EpiResid2); }
            else { pg8::EpiResid E{HH, HH, DM, 1.0f}; GEMM_PH(pg8::EpiResid); } }
        SEAM_L(pb + 11);
        if (IN(pb + 12)) { IDS if (!ST_NORM) { nv_norm_rows(HH, PIN(I_CRN) + l * DM, WSB(WS_XN), M, gw, NGW, lane); nv_norm_rows(PIN(I_MEM), PIN(I_MEMN) + l * DM, WSB(WS_MEMN), MMEM, gw, NGW, lane); } }
        if (!ST_NORM) SEAM(pb + 12);
        if (IN(pb + 13)) for (int rep = 0; rep < REPS(13); ++rep) { IDS
            { pg8::Gemm g{WSB(WS_XN), WL(l) + WO_CQ, M, 512, DM, DM, DM}; pg8::StaticOrder S; S.init(M, 512, G, cv);
              if (ST_NORM) { RCACHE_DEF(32, WSF(WS_STATS), 1.0f / 2048.0f) pg8::EpiMix<32> E{WSB(WS_CQ2), 512, WSF(WS_STATS), 1.0f / 2048.0f, 2, nullptr, nullptr, nullptr, nullptr, nullptr, nullptr, rc_, PRESC_CROSS ? QS_CROSS : 1.0f}; GEMM_PH(pg8::EpiMix<32>); }
              else { pg8::EpiBf16 E{WSB(WS_CQ2), 512}; GEMM_PH(pg8::EpiBf16); } }
        }
        SEAM_L(pb + 13);
        if (IN(pb + 14)) for (int rep = 0; rep < REPS(14); ++rep) { IDS char* lp = (char*)lds_raw + RING_OFF; for (int u = lok ? (32 * xcc + xrank) : bx; u < (M / 256) * 4; u += G) { const int tidu = wave * 64 + fresh_lane(); unit_cross(u >> 2, u & 3, WSB(WS_CQ2), WSB(WS_KVC), WSB(WS_OC), lp, tidu); } }
        SEAM_L(pb + 14);
        if (IN(pb + 15)) for (int rep = 0; rep < REPS(15); ++rep) { IDS pg8::Gemm g{WSB(WS_OC), WL(l) + WO_CO, M, DM, 512, 512, 512}; pg8::StaticOrder S; S.init(M, DM, G, cv);
            if (ST_HILO) { pg8::EpiResid3 E{WSB(WS_XN), (ST_HILO == 2) ? nullptr : WSB(WS_LO), WSF(WS_STATS), DM, rep ? 0.0f : 1.0f}; GEMM_PH(pg8::EpiResid3); }
            else if (ST_NORM) { pg8::EpiResid2 E{HH, HH, WSB(WS_XN), WSF(WS_STATS), DM, rep ? 0.0f : 1.0f}; GEMM_PH(pg8::EpiResid2); }
            else { pg8::EpiResid E{HH, HH, DM, 1.0f}; GEMM_PH(pg8::EpiResid); } }
        SEAM_L(pb + 15);
        FFN_PHASES(16, I_F2N, WO_GU2, WO_D2, ((const float*)HH))
#undef FFN_PHASES
    }
    if (IN(PH_TOTAL - 1)) { IDS
        if (ST_HILO) final_norm_hilo(WSB(WS_XN), (ST_HILO == 2) ? nullptr : WSB(WS_LO), HH, PIN(I_FINN), pair * SEQ + pidx * NWAVES + wave, lok ? (pair + 1) * SEQ : M, PG * NWAVES, lane);
        else nv_final_norm(HH, PIN(I_FINN), gw, NGW, lane); }
#undef IN
#undef SEAM
#undef IDS
#undef PIN
#undef WS
#undef CTLP
#undef HH
#undef WSB
#undef WSF
#undef WL
#undef GEMM_PH
#undef RCACHE_DEF
}

#ifndef MK_ONE_LAUNCH
#define MK_ONE_LAUNCH 1
#endif
extern "C" void kernel_launch(void* const* d_in, const int* in_sizes, int n_in, void* d_out, int out_size, void* d_ws, size_t ws_size, hipStream_t stream) {
    static int grid = 0;
    if (grid == 0) {
        if (n_in != 26 || in_sizes[0] != M * DM || out_size != M * DM || ws_size < WS_END) {
            fprintf(stderr, "kernel_launch: shape mismatch: n_in %d in0 %d out %d ws %zu (need %zu); not((l == 0) ? PIN(I_X) : (const float*)H)g launched\n", n_in, n_in > 0 ? in_sizes[0] : -1, out_size, ws_size, (size_t)WS_END); grid = -1; return; }
        int dev = 0, cus = 0, per_cu = 0;
        if (hipGetDevice(&dev) != hipSuccess || hipDeviceGetAttribute(&cus, hipDeviceAttributeMultiprocessorCount, dev) != hipSuccess) { grid = -1; return; }
        if (hipFuncSetAttribute((const void*)mk_fwd, hipFuncAttributeMaxDynamicSharedMemorySize, LDS_BYTES) != hipSuccess) { fprintf(stderr, "kernel_launch: hipFuncSetAttribute failed\n"); grid = -1; return; }
        if (hipOccupancyMaxActiveBlocksPerMultiprocessor(&per_cu, (const void*)mk_fwd, NWAVES * 64, LDS_BYTES) != hipSuccess || per_cu < 1) fprintf(stderr, "kernel_launch: occupancy query says %d\n", per_cu);
        (void)hipGetLastError();
        grid = cus;
    }
    if (grid < 0) return;
    if (hipMemsetAsync((char*)d_ws + WS_CTL, 0, CTL_ZERO_BYTES, stream) != hipSuccess) return;
    Params p{};
    for (int i = 0; i < 26; ++i) p.in[i] = (const float*)d_in[i];
    p.out = (float*)d_out; p.ws = (unsigned char*)d_ws;
    for (int i = 0; i < 32; ++i) p.inv64[i] = (float)(1.0 / pow(10000.0, (double)(2 * i) / 64.0));
    for (int i = 0; i < 64; ++i) p.inv128[i] = (float)(1.0 / pow(10000.0, (double)(2 * i) / 128.0));
    for (int l = 0; l < DEPTH; ++l) p.lam_init[l] = (float)(0.8 - 0.6 * exp(-0.3 * (double)l));
    p.pad = 0;
#if MK_ONE_LAUNCH
    p.ph_lo = 0; p.ph_hi = PH_TOTAL; p.use_bar = 1;
    hipLaunchKernelGGL(mk_fwd, dim3(grid), dim3(NWAVES * 64), LDS_BYTES, stream, p);
#else
    p.use_bar = 0;
    for (int ph = 0; ph < PH_TOTAL; ++ph) { p.ph_lo = ph; p.ph_hi = ph + 1; hipLaunchKernelGGL(mk_fwd, dim3(grid), dim3(NWAVES * 64), LDS_BYTES, stream, p); }
#endif
    const hipError_t le = hipPeekAtLastError();
    if (le != hipSuccess) fprintf(stderr, "kernel_launch: launch failed: %s\n", hipGetErrorName(le));
}
```
